# Optimizing an MI355X kernel written in HIP

```python
import math
import jax
import jax.numpy as jnp
from jax import lax
import numpy as np

D_MODEL = 1024
BATCH = 1
SEQ = 16384
DEPTH = 4
DEC_BATCH = 16
DEC_SEQ = 16
PAST_LEN = 4096

CHUNK = 64
N_META = 16
N_MIXERS = 3
N_SSD_LAYERS = len(range(0, DEPTH, N_MIXERS))
N_DA_LAYERS = len(range(1, DEPTH, N_MIXERS))
N_RK_LAYERS = len(range(2, DEPTH, N_MIXERS))

SSD_INNER = 2 * D_MODEL
SSD_HEADDIM = 64
SSD_HEADS = SSD_INNER // SSD_HEADDIM
SSD_GROUPS = 8
SSD_HPG = SSD_HEADS // SSD_GROUPS
SSD_STATE = 128
SSD_CONV = 4
SSD_CONV_DIM = SSD_INNER + 2 * SSD_GROUPS * SSD_STATE
SSD_PROJ = SSD_INNER + SSD_CONV_DIM + SSD_HEADS
SSD_BLOCK = 64
SSD_NORM_EPS = 1e-5

DA_HD = 64
DA_HEADS = D_MODEL // (2 * DA_HD)
Q_BLOCK = 128
ROPE_THETA = 10000.0
SUBLN_EPS = 1e-5

RK_HD = 64
RK_HEADS = D_MODEL // RK_HD
RK_DECAY_LORA = 64
RK_AAA_LORA = 64
RK_GATE_LORA = 160
RK_GN_EPS = 64e-5

D_FF = 2816
FFN_CONV = 3

LN_EPS = 1e-5
DEEPNORM_ALPHA = (2 * DEPTH) ** 0.25
DEEPNORM_BETA = (8 * DEPTH) ** -0.25

SSD_NAMES = ('ssd_w_in', 'ssd_conv_w', 'ssd_conv_b', 'ssd_dt_bias', 'ssd_a_log', 'ssd_d', 'ssd_norm_w', 'ssd_w_out')
DA_NAMES = ('da_w_qkv', 'da_lambda', 'da_subln_g', 'da_w_o')
RK_NAMES = ('rk_mu', 'rk_w0', 'rk_w1', 'rk_w2', 'rk_a0', 'rk_a1', 'rk_a2', 'rk_g1', 'rk_g2', 'rk_k_k', 'rk_k_a',
            'rk_r_k', 'rk_w_r', 'rk_w_k', 'rk_w_v', 'rk_w_o', 'rk_lnx_g', 'rk_lnx_b')
FFN_NAMES = ('ffn_w_up', 'ffn_w_gate', 'ffn_conv_w', 'ffn_conv_b', 'ffn_w_down')
STATE_NAMES = ('k', 'v', 'ssm', 'ssd_conv', 'wkv', 'shift', 'ffn_conv')

kernel_name = 'hybrid_ssd_diffattn_rwkv7_convffn_stream_step'


def layer_norm(x, g, b):
    xf = x.astype(jnp.float32)
    mu = jnp.mean(xf, axis=-1, keepdims=True)
    var = jnp.mean(jnp.square(xf - mu), axis=-1, keepdims=True)
    return ((xf - mu) * lax.rsqrt(var + LN_EPS) * g + b).astype(x.dtype)


def rms_norm(x, g, eps):
    xf = x.astype(jnp.float32)
    return (xf * lax.rsqrt(jnp.mean(jnp.square(xf), axis=-1, keepdims=True) + eps) * g).astype(x.dtype)


def causal_dwconv(x, prev, w, b):
    width, l = w.shape[0], x.shape[1]
    xp = jnp.concatenate([prev.astype(x.dtype), x], axis=1)
    out = b
    for j in range(width):
        out = out + xp[:, j:j + l] * w[j]
    return out, xp[:, -(width - 1):]


def rotary(x, pos):
    half = x.shape[-1] // 2
    inv = ROPE_THETA ** (-jnp.arange(half, dtype=jnp.float32) / half)
    ang = pos.astype(jnp.float32)[:, None] * inv[None, :]
    shape = (1, x.shape[1]) + (1,) * (x.ndim - 3) + (half,)
    cos, sin = jnp.cos(ang).reshape(shape), jnp.sin(ang).reshape(shape)
    x1, x2 = x[..., :half], x[..., half:]
    return jnp.concatenate([x1 * cos - x2 * sin, x2 * cos + x1 * sin], axis=-1).astype(x.dtype)


def ssd_scan(xs, dt, a, bm, cm, s0):
    bt, l = xs.shape[:2]
    nc = -(-l // SSD_BLOCK)
    pad = nc * SSD_BLOCK - l

    def blocks(t):
        t = jnp.pad(t, ((0, 0), (0, pad)) + ((0, 0),) * (t.ndim - 2))
        return t.reshape((bt, nc, SSD_BLOCK) + t.shape[2:])

    xdt = blocks(xs * dt[..., None])
    adt = jnp.moveaxis(blocks(dt * a), 2, -1)
    bb, cc = blocks(bm), blocks(cm)
    acs = jnp.cumsum(adt, axis=-1)
    causal = jnp.tril(jnp.ones((SSD_BLOCK, SSD_BLOCK), dtype=bool))
    seg = acs[..., :, None] - acs[..., None, :]
    lmat = jnp.where(causal, jnp.exp(jnp.where(causal, seg, 0.0)), 0.0)
    cb = jnp.einsum('bclgn,bcsgn->bcgls', cc, bb)
    y_diag = jnp.einsum('bcgls,bcgrls,bcsgrp->bclgrp', cb, lmat, xdt)
    decay_to_end = jnp.exp(acs[..., -1:] - acs)
    chunk_states = jnp.einsum('bclgn,bcgrl,bclgrp->bcgrpn', bb, decay_to_end, xdt).astype(jnp.float32)
    chunk_decay = jnp.exp(acs[..., -1])

    def step(s, inp):
        cs, cd = inp
        return s * cd[..., None, None] + cs, s

    s_init = s0.astype(jnp.float32).reshape(bt, SSD_GROUPS, SSD_HPG, SSD_HEADDIM, SSD_STATE)
    s_final, s_prev = lax.scan(step, s_init, (jnp.moveaxis(chunk_states, 1, 0), jnp.moveaxis(chunk_decay, 1, 0)))
    s_prev = jnp.moveaxis(s_prev, 0, 1)
    y_off = jnp.einsum('bclgn,bcgrpn,bcgrl->bclgrp', cc, s_prev, jnp.exp(acs))
    y = (y_diag + y_off).reshape((bt, nc * SSD_BLOCK) + xs.shape[2:])[:, :l]
    return y, s_final.reshape(bt, SSD_HEADS, SSD_HEADDIM, SSD_STATE)


def mamba_mixer(x, conv_prev, ssm_prev, w_in, conv_w, conv_b, dt_bias, a_log, d_skip, norm_w, w_out):
    bt, l, _ = x.shape
    proj = x @ w_in
    z = proj[..., :SSD_INNER]
    xbc = proj[..., SSD_INNER:SSD_INNER + SSD_CONV_DIM]
    dt_raw = proj[..., SSD_INNER + SSD_CONV_DIM:]
    xbc, conv_new = causal_dwconv(xbc, conv_prev, conv_w, conv_b)
    xbc = jax.nn.silu(xbc)
    gn = SSD_GROUPS * SSD_STATE
    xs = xbc[..., :SSD_INNER].reshape(bt, l, SSD_GROUPS, SSD_HPG, SSD_HEADDIM)
    bm = xbc[..., SSD_INNER:SSD_INNER + gn].reshape(bt, l, SSD_GROUPS, SSD_STATE)
    cm = xbc[..., SSD_INNER + gn:].reshape(bt, l, SSD_GROUPS, SSD_STATE)
    dt = jax.nn.softplus((dt_raw + dt_bias).astype(jnp.float32)).reshape(bt, l, SSD_GROUPS, SSD_HPG)
    a = -jnp.exp(a_log.astype(jnp.float32)).reshape(SSD_GROUPS, SSD_HPG)
    y, ssm_new = ssd_scan(xs, dt, a, bm, cm, ssm_prev)
    y = y + d_skip.reshape(SSD_GROUPS, SSD_HPG)[..., None] * xs
    y = y.reshape(bt, l, SSD_INNER).astype(x.dtype)
    y = rms_norm(y * jax.nn.silu(z), norm_w, SSD_NORM_EPS)
    return y @ w_out, conv_new, ssm_new.astype(x.dtype)


def diff_attention(q, k, v, q_chunk, k_chunk, lam):
    bt, lq = q.shape[:2]
    qb = min(Q_BLOCK, lq)
    nb = -(-lq // qb)
    pad = nb * qb - lq
    qp = jnp.pad(q, ((0, 0), (0, pad), (0, 0), (0, 0), (0, 0)))
    qp = jnp.swapaxes(qp.reshape((bt, nb, qb) + q.shape[2:]), 0, 1)
    qcp = jnp.pad(q_chunk, (0, pad), mode='edge').reshape(nb, qb)
    scale = DA_HD ** -0.5

    def block(args):
        qblk, qc = args
        s = jnp.einsum('bqhcd,bkhcd->bhcqk', qblk, k).astype(jnp.float32) * scale
        visible = k_chunk[None, :] <= qc[:, None]
        p = jax.nn.softmax(jnp.where(visible, s, -jnp.inf), axis=-1)
        attn = p[:, :, 0] - lam * p[:, :, 1]
        return jnp.einsum('bhqk,bkhe->bqhe', attn.astype(v.dtype), v)

    out = lax.map(block, (qp, qcp))
    return jnp.swapaxes(out, 0, 1).reshape(bt, nb * qb, DA_HEADS, 2 * DA_HD)[:, :lq]


def diff_attn_mixer(x, pos, q_chunk, k_chunk, k_past, v_past, w_qkv, lam_p, subln_g, w_o, lam_init):
    bt, l, _ = x.shape
    q, k, v = jnp.split(x @ w_qkv, 3, axis=-1)
    q = rotary(q.reshape(bt, l, DA_HEADS, 2, DA_HD), pos)
    k = rotary(k.reshape(bt, l, DA_HEADS, 2, DA_HD), pos)
    v = v.reshape(bt, l, DA_HEADS, 2 * DA_HD)
    lp = lam_p.astype(jnp.float32)
    lam = jnp.exp(jnp.sum(lp[0] * lp[1])) - jnp.exp(jnp.sum(lp[2] * lp[3])) + lam_init
    k_all = jnp.concatenate([k_past.astype(k.dtype), k], axis=1)
    v_all = jnp.concatenate([v_past.astype(v.dtype), v], axis=1)
    o = diff_attention(q, k_all, v_all, q_chunk, k_chunk, lam)
    o = rms_norm(o, subln_g, SUBLN_EPS) * (1.0 - lam_init)
    return o.reshape(bt, l, D_MODEL) @ w_o, k, v


def wkv7_scan(r, w, k, v, a, b, s0):
    def step(s, inp):
        rt, wt, kt, vt, at, btt = inp
        sa = jnp.einsum('bhvk,bhk->bhv', s, at)
        s = s * wt[:, :, None, :] + sa[..., None] * btt[:, :, None, :] + vt[..., None] * kt[:, :, None, :]
        return s, jnp.einsum('bhvk,bhk->bhv', s, rt)

    seq = tuple(jnp.swapaxes(t.astype(jnp.float32), 0, 1) for t in (r, w, k, v, a, b))
    s_final, y = lax.scan(step, s0.astype(jnp.float32), seq)
    return jnp.swapaxes(y, 0, 1), s_final


def rwkv_mixer(x, shift_prev, wkv_prev, mu, w0, w1, w2, a0, a1, a2, g1, g2, k_k, k_a, r_k,
               w_r, w_k, w_v, w_o, lnx_g, lnx_b):
    bt, l, _ = x.shape
    x_prev = jnp.concatenate([shift_prev.astype(x.dtype), x[:, :-1]], axis=1)
    xx = x_prev - x
    xr, xw, xk, xv, xa, xg = (x + xx * mu[n] for n in range(6))
    r, k, v = xr @ w_r, xk @ w_k, xv @ w_v
    w_log = -jax.nn.softplus(-(w0 + jnp.tanh(xw @ w1) @ w2).astype(jnp.float32)) - 0.5
    decay = jnp.exp(-jnp.exp(w_log))
    a = jax.nn.sigmoid(a0 + (xa @ a1) @ a2)
    g = jax.nn.sigmoid(xg @ g1) @ g2

    def heads(t):
        return t.reshape(bt, l, RK_HEADS, RK_HD)

    kk = heads(k * k_k).astype(jnp.float32)
    kk = kk / jnp.maximum(jnp.sqrt(jnp.sum(jnp.square(kk), axis=-1, keepdims=True)), 1e-12)
    k = k * (1.0 + (a - 1.0) * k_a)
    r_h, k_h, v_h, a_h = heads(r), heads(k), heads(v), heads(a)
    y, wkv_new = wkv7_scan(r_h, heads(decay), k_h, v_h, -kk, kk * a_h, wkv_prev)
    mean = jnp.mean(y, axis=-1, keepdims=True)
    var = jnp.mean(jnp.square(y - mean), axis=-1, keepdims=True)
    y = ((y - mean) * lax.rsqrt(var + RK_GN_EPS)).reshape(bt, l, D_MODEL) * lnx_g + lnx_b
    bonus = jnp.sum(r_h * k_h * r_k, axis=-1, keepdims=True) * v_h
    y = (y + bonus.reshape(bt, l, D_MODEL)).astype(x.dtype)
    return (y * g) @ w_o, x[:, -1:], wkv_new.astype(x.dtype)


def conv_ffn(x, conv_prev, w_up, w_gate, conv_w, conv_b, w_down):
    gate, conv_new = causal_dwconv(x @ w_gate, conv_prev, conv_w, conv_b)
    return (jax.nn.silu(gate) * (x @ w_up)) @ w_down, conv_new


def trunk(x, pos, q_chunk, k_chunk, hist, params):
    new = {name: [] for name in STATE_NAMES}
    for i in range(DEPTH):
        j, kind = i // N_MIXERS, i % N_MIXERS
        if kind == 0:
            y, conv_new, ssm_new = mamba_mixer(x, hist['ssd_conv'][j], hist['ssm'][j],
                                               *[params[n][j] for n in SSD_NAMES])
            new['ssd_conv'].append(conv_new)
            new['ssm'].append(ssm_new)
        elif kind == 1:
            lam_init = 0.8 - 0.6 * math.exp(-0.3 * i)
            y, k_new, v_new = diff_attn_mixer(x, pos, q_chunk, k_chunk, hist['k'][j], hist['v'][j],
                                              *[params[n][j] for n in DA_NAMES], lam_init)
            new['k'].append(k_new)
            new['v'].append(v_new)
        else:
            y, shift_new, wkv_new = rwkv_mixer(x, hist['shift'][j], hist['wkv'][j],
                                               *[params[n][j] for n in RK_NAMES])
            new['shift'].append(shift_new)
            new['wkv'].append(wkv_new)
        x = layer_norm(DEEPNORM_ALPHA * x + y, params['ln_g'][i, 0], params['ln_b'][i, 0])
        f, fconv_new = conv_ffn(x, hist['ffn_conv'][i], *[params[n][i] for n in FFN_NAMES])
        new['ffn_conv'].append(fconv_new)
        x = layer_norm(DEEPNORM_ALPHA * x + f, params['ln_g'][i, 1], params['ln_b'][i, 1])
    return x, tuple(jnp.stack(new[n]) for n in STATE_NAMES)


def setup_inputs(seed: int = 0) -> dict:
    key = jax.random.key(seed)
    ks = iter(jax.random.split(key, 64))

    def nrm(shape, scale):
        return jax.random.normal(next(ks), shape, jnp.float32) * scale

    def uni(shape, lo, hi):
        return jax.random.uniform(next(ks), shape, jnp.float32, lo, hi)

    d = D_MODEL
    dt0 = jnp.exp(uni((N_SSD_LAYERS, SSD_HEADS), math.log(1e-3), math.log(1e-1)))
    return {
        'x_prompt': nrm((BATCH, SEQ, d), 1.0),
        'x_sample': nrm((DEC_BATCH, DEC_SEQ, d), 1.0),
        'cache_attn_k': nrm((N_DA_LAYERS, DEC_BATCH, PAST_LEN, DA_HEADS, 2, DA_HD), 1.0),
        'cache_attn_v': nrm((N_DA_LAYERS, DEC_BATCH, PAST_LEN, DA_HEADS, 2 * DA_HD), 1.0),
        'state_ssm': nrm((N_SSD_LAYERS, DEC_BATCH, SSD_HEADS, SSD_HEADDIM, SSD_STATE), 0.1),
        'state_ssd_conv': nrm((N_SSD_LAYERS, DEC_BATCH, SSD_CONV - 1, SSD_CONV_DIM), 1.0),
        'state_wkv': nrm((N_RK_LAYERS, DEC_BATCH, RK_HEADS, RK_HD, RK_HD), 0.1),
        'state_rwkv_shift': nrm((N_RK_LAYERS, DEC_BATCH, 1, d), 1.0),
        'state_ffn_conv': nrm((DEPTH, DEC_BATCH, FFN_CONV - 1, D_FF), 1.0),
        'meta_tokens': nrm((N_META, d), 1.0),
        'ssd_w_in': nrm((N_SSD_LAYERS, d, SSD_PROJ), d ** -0.5),
        'ssd_conv_w': nrm((N_SSD_LAYERS, SSD_CONV, SSD_CONV_DIM), SSD_CONV ** -0.5),
        'ssd_conv_b': nrm((N_SSD_LAYERS, SSD_CONV_DIM), 0.02),
        'ssd_dt_bias': dt0 + jnp.log(-jnp.expm1(-dt0)),
        'ssd_a_log': jnp.log(uni((N_SSD_LAYERS, SSD_HEADS), 1.0, 16.0)),
        'ssd_d': 1.0 + nrm((N_SSD_LAYERS, SSD_HEADS), 0.1),
        'ssd_norm_w': 1.0 + nrm((N_SSD_LAYERS, SSD_INNER), 0.02),
        'ssd_w_out': nrm((N_SSD_LAYERS, SSD_INNER, d), SSD_INNER ** -0.5 * DEEPNORM_BETA),
        'da_w_qkv': nrm((N_DA_LAYERS, d, 3 * d), d ** -0.5),
        'da_lambda': nrm((N_DA_LAYERS, 4, DA_HD), 0.1),
        'da_subln_g': 1.0 + nrm((N_DA_LAYERS, 2 * DA_HD), 0.02),
        'da_w_o': nrm((N_DA_LAYERS, d, d), d ** -0.5 * DEEPNORM_BETA),
        'rk_mu': uni((N_RK_LAYERS, 6, d), 0.0, 1.0),
        'rk_w0': uni((N_RK_LAYERS, d), -6.0, 0.0),
        'rk_w1': nrm((N_RK_LAYERS, d, RK_DECAY_LORA), d ** -0.5),
        'rk_w2': nrm((N_RK_LAYERS, RK_DECAY_LORA, d), 0.1 * RK_DECAY_LORA ** -0.5),
        'rk_a0': nrm((N_RK_LAYERS, d), 0.1),
        'rk_a1': nrm((N_RK_LAYERS, d, RK_AAA_LORA), d ** -0.5),
        'rk_a2': nrm((N_RK_LAYERS, RK_AAA_LORA, d), 0.1 * RK_AAA_LORA ** -0.5),
        'rk_g1': nrm((N_RK_LAYERS, d, RK_GATE_LORA), d ** -0.5),
        'rk_g2': nrm((N_RK_LAYERS, RK_GATE_LORA, d), RK_GATE_LORA ** -0.5),
        'rk_k_k': 0.85 + nrm((N_RK_LAYERS, d), 0.02),
        'rk_k_a': 1.0 + nrm((N_RK_LAYERS, d), 0.02),
        'rk_r_k': nrm((N_RK_LAYERS, RK_HEADS, RK_HD), 0.1),
        'rk_w_r': nrm((N_RK_LAYERS, d, d), d ** -0.5),
        'rk_w_k': nrm((N_RK_LAYERS, d, d), d ** -0.5),
        'rk_w_v': nrm((N_RK_LAYERS, d, d), d ** -0.5),
        'rk_w_o': nrm((N_RK_LAYERS, d, d), d ** -0.5 * DEEPNORM_BETA),
        'rk_lnx_g': 1.0 + nrm((N_RK_LAYERS, d), 0.02),
        'rk_lnx_b': nrm((N_RK_LAYERS, d), 0.02),
        'ffn_w_up': nrm((DEPTH, d, D_FF), d ** -0.5),
        'ffn_w_gate': nrm((DEPTH, d, D_FF), d ** -0.5),
        'ffn_conv_w': nrm((DEPTH, FFN_CONV, D_FF), FFN_CONV ** -0.5),
        'ffn_conv_b': nrm((DEPTH, D_FF), 0.02),
        'ffn_w_down': nrm((DEPTH, D_FF, d), D_FF ** -0.5 * DEEPNORM_BETA),
        'ln_g': 1.0 + nrm((DEPTH, 2, d), 0.02),
        'ln_b': nrm((DEPTH, 2, d), 0.02),
    }


def reference(x_prompt, x_sample, cache_attn_k, cache_attn_v, state_ssm, state_ssd_conv, state_wkv,
              state_rwkv_shift, state_ffn_conv, meta_tokens, ssd_w_in, ssd_conv_w, ssd_conv_b, ssd_dt_bias,
              ssd_a_log, ssd_d, ssd_norm_w, ssd_w_out, da_w_qkv, da_lambda, da_subln_g, da_w_o, rk_mu, rk_w0,
              rk_w1, rk_w2, rk_a0, rk_a1, rk_a2, rk_g1, rk_g2, rk_k_k, rk_k_a, rk_r_k, rk_w_r, rk_w_k, rk_w_v,
              rk_w_o, rk_lnx_g, rk_lnx_b, ffn_w_up, ffn_w_gate, ffn_conv_w, ffn_conv_b, ffn_w_down, ln_g, ln_b):
    params = dict(ssd_w_in=ssd_w_in, ssd_conv_w=ssd_conv_w, ssd_conv_b=ssd_conv_b, ssd_dt_bias=ssd_dt_bias,
                  ssd_a_log=ssd_a_log, ssd_d=ssd_d, ssd_norm_w=ssd_norm_w, ssd_w_out=ssd_w_out,
                  da_w_qkv=da_w_qkv, da_lambda=da_lambda, da_subln_g=da_subln_g, da_w_o=da_w_o,
                  rk_mu=rk_mu, rk_w0=rk_w0, rk_w1=rk_w1, rk_w2=rk_w2, rk_a0=rk_a0, rk_a1=rk_a1, rk_a2=rk_a2,
                  rk_g1=rk_g1, rk_g2=rk_g2, rk_k_k=rk_k_k, rk_k_a=rk_k_a, rk_r_k=rk_r_k, rk_w_r=rk_w_r,
                  rk_w_k=rk_w_k, rk_w_v=rk_w_v, rk_w_o=rk_w_o, rk_lnx_g=rk_lnx_g, rk_lnx_b=rk_lnx_b,
                  ffn_w_up=ffn_w_up, ffn_w_gate=ffn_w_gate, ffn_conv_w=ffn_conv_w, ffn_conv_b=ffn_conv_b,
                  ffn_w_down=ffn_w_down, ln_g=ln_g, ln_b=ln_b)

    bp, dtp = x_prompt.shape[0], x_prompt.dtype
    meta = jnp.broadcast_to(meta_tokens.astype(dtp)[None], (bp, N_META, D_MODEL))
    xp = jnp.concatenate([meta, x_prompt], axis=1)
    pos_p = jnp.arange(xp.shape[1])
    chunk_p = (pos_p - N_META) // CHUNK + 1
    hist_p = dict(
        k=jnp.zeros((N_DA_LAYERS, bp, 0, DA_HEADS, 2, DA_HD), dtp),
        v=jnp.zeros((N_DA_LAYERS, bp, 0, DA_HEADS, 2 * DA_HD), dtp),
        ssm=jnp.zeros((N_SSD_LAYERS, bp, SSD_HEADS, SSD_HEADDIM, SSD_STATE), dtp),
        ssd_conv=jnp.zeros((N_SSD_LAYERS, bp, SSD_CONV - 1, SSD_CONV_DIM), dtp),
        wkv=jnp.zeros((N_RK_LAYERS, bp, RK_HEADS, RK_HD, RK_HD), dtp),
        shift=jnp.zeros((N_RK_LAYERS, bp, 1, D_MODEL), dtp),
        ffn_conv=jnp.zeros((DEPTH, bp, FFN_CONV - 1, D_FF), dtp))
    yp, (k_p, v_p, ssm_p, sc_p, wkv_p, sh_p, fc_p) = trunk(xp, pos_p, chunk_p, chunk_p, hist_p, params)
    y_prompt = yp[:, N_META:]

    ls, past = x_sample.shape[1], cache_attn_k.shape[2]
    pos_s = past + jnp.arange(ls)
    hist_s = dict(k=cache_attn_k, v=cache_attn_v, ssm=state_ssm, ssd_conv=state_ssd_conv, wkv=state_wkv,
                  shift=state_rwkv_shift, ffn_conv=state_ffn_conv)
    y_sample, (k_s, v_s, ssm_s, sc_s, wkv_s, sh_s, fc_s) = trunk(
        x_sample, pos_s, pos_s // CHUNK, jnp.arange(past + ls) // CHUNK, hist_s, params)

    return (y_prompt, y_sample, k_p, v_p, ssm_p, sc_p, wkv_p, sh_p, fc_p,
            k_s, v_s, ssm_s, sc_s, wkv_s, sh_s, fc_s)
```

```cpp
#include <hip/hip_runtime.h>
#include <hip/hip_cooperative_groups.h>
#include <cstdio>
#include <cstdint>
namespace cg = cooperative_groups;

typedef unsigned short bf16;
typedef __attribute__((ext_vector_type(8))) short bf16x8;
typedef __attribute__((ext_vector_type(16))) float f32x16;
typedef __attribute__((ext_vector_type(4))) unsigned u32x4;
typedef __attribute__((ext_vector_type(4))) float f32x4;

#define DEVI __device__ __forceinline__

#ifndef MK_COOP
#define MK_COOP 1
#endif

constexpr int D = 1024, TP = 16400, NB = 16, M = 16656, MP = 16768, MT = 131;
constexpr int NCH = 273;
constexpr int LDVP = 16448, LDVS = 4160;
constexpr int KROWS = LDVP + NB * LDVS;
constexpr float ALPHA = 1.681792830507429f;
constexpr float LAM_INIT = 0.35550906f;
constexpr int SMEM_BYTES = 73728;

constexpr size_t O_YP = 0;
constexpr size_t O_YS = O_YP + (size_t)16384 * 1024;
constexpr size_t O_KP = O_YS + (size_t)256 * 1024;
constexpr size_t O_VP = O_KP + (size_t)TP * 1024;
constexpr size_t O_SSMP = O_VP + (size_t)TP * 1024;
constexpr size_t O_SCP = O_SSMP + (size_t)2 * 32 * 64 * 128;
constexpr size_t O_WKVP = O_SCP + (size_t)2 * 3 * 4096;
constexpr size_t O_SHP = O_WKVP + (size_t)16 * 64 * 64;
constexpr size_t O_FCP = O_SHP + 1024;
constexpr size_t O_KS = O_FCP + (size_t)4 * 2 * 2816;
constexpr size_t O_VS = O_KS + (size_t)256 * 1024;
constexpr size_t O_SSMS = O_VS + (size_t)256 * 1024;
constexpr size_t O_SCS = O_SSMS + (size_t)2 * 16 * 32 * 64 * 128;
constexpr size_t O_WKVS = O_SCS + (size_t)2 * 16 * 3 * 4096;
constexpr size_t O_SHS = O_WKVS + (size_t)16 * 16 * 64 * 64;
constexpr size_t O_FCS = O_SHS + (size_t)16 * 1024;
constexpr size_t O_TOTAL = O_FCS + (size_t)4 * 16 * 2 * 2816;

struct Params {
  const float* in[47];
  float* out;
  char* ws;
};
DEVI int lnd(int i) { asm volatile("" : "+s"(i)); return i; }
#define GAS __attribute__((address_space(1)))
DEVI const float* gl_in(const float* q) {
  unsigned long long v = (unsigned long long)q;
  asm volatile("" : "+s"(v));
  return (const float*)(const GAS float*)v;
}
#define PIN(i) (gl_in(p.in[lnd(i)]))
DEVI char* lndp(char* x) {
  unsigned long long v = (unsigned long long)x;
  asm volatile("" : "+s"(v));
  return (char*)(GAS char*)v;
}
DEVI float* lndf(float* x) {
  unsigned long long v = (unsigned long long)x;
  asm volatile("" : "+s"(v));
  return (float*)(GAS float*)v;
}
#define PW(T, off) ((T*)(lndp(p.ws) + (off)))
#define POUT (lndf(p.out))


constexpr size_t AL(size_t x) { return (x + 255) & ~(size_t)255; }
constexpr size_t S_ZB = 0;
constexpr size_t S_XBC = S_ZB + AL((size_t)MP * 2048 * 2);
constexpr size_t S_XC = S_XBC + AL((size_t)MP * 4096 * 2);
constexpr size_t S_XT = S_XC + AL((size_t)MP * 4096 * 2);
constexpr size_t S_BT = S_XT + AL((size_t)NCH * 2048 * 64 * 2);
constexpr size_t S_DTRAW = S_BT + AL((size_t)NCH * 1024 * 64 * 2);
constexpr size_t S_DT = S_DTRAW + AL((size_t)MP * 32 * 4);
constexpr size_t S_CS = S_DT + AL((size_t)MP * 32 * 4);
constexpr size_t S_CD = S_CS + AL((size_t)NCH * 32 * 64 * 128 * 2);
constexpr size_t S_END = S_CD + AL((size_t)NCH * 32 * 4);
constexpr size_t S_YS = S_XBC;
constexpr size_t S_YB = S_XBC + AL((size_t)MP * 2048 * 2);
constexpr size_t F_GU = 0;
constexpr size_t F_HB = F_GU + AL((size_t)MP * 5632 * 2);
constexpr size_t F_END = F_HB + AL((size_t)MP * 2816 * 2);
constexpr size_t A_QB = 0;
constexpr size_t A_KALL = A_QB + AL((size_t)MP * 1024 * 2);
constexpr size_t A_VTP = A_KALL + AL((size_t)KROWS * 1024 * 2);
constexpr size_t A_VTS = A_VTP + AL((size_t)1024 * LDVP * 2);
constexpr size_t A_OB = A_VTS + AL((size_t)NB * 1024 * LDVS * 2);
constexpr size_t A_END = A_OB + AL((size_t)MP * 1024 * 2);
constexpr size_t R_MIX = 0;
constexpr size_t R_R = R_MIX + AL((size_t)6 * MP * 1024 * 2);
constexpr size_t R_K = R_R + AL((size_t)MP * 1024 * 4);
constexpr size_t R_V = R_K + AL((size_t)MP * 1024 * 4);
constexpr size_t R_HW = R_V + AL((size_t)MP * 1024 * 4);
constexpr size_t R_HA = R_HW + AL((size_t)MP * 64 * 2);
constexpr size_t R_HG = R_HA + AL((size_t)MP * 64 * 2);
constexpr size_t R_KK = R_HG + AL((size_t)MP * 192 * 2);
constexpr size_t R_BV = R_KK + AL((size_t)MP * 1024 * 4);
constexpr size_t R_Y = R_BV + AL((size_t)MP * 1024 * 4);
constexpr size_t R_YB = R_Y + AL((size_t)MP * 1024 * 4);
constexpr size_t R_END = R_YB + AL((size_t)MP * 1024 * 2);
constexpr size_t R_W = R_MIX;
constexpr size_t R_A = R_MIX + (size_t)MP * 1024 * 4;
constexpr size_t R_G = R_MIX + (size_t)2 * MP * 1024 * 4;
constexpr size_t cmax(size_t a, size_t b) { return a > b ? a : b; }
constexpr size_t ARENA_BYTES = cmax(cmax(S_END, F_END), cmax(A_END, R_END));
constexpr size_t W_counters = 0;
constexpr size_t W_wt_ssd_in = W_counters + AL(16384);
constexpr size_t W_wt_ssd_out = W_wt_ssd_in + AL((size_t)2 * 6272 * 1024 * 2);
constexpr size_t W_wt_qkv = W_wt_ssd_out + AL((size_t)2 * 1024 * 2048 * 2);
constexpr size_t W_wt_o = W_wt_qkv + AL((size_t)3072 * 1024 * 2);
constexpr size_t W_wt_r = W_wt_o + AL((size_t)1024 * 1024 * 2);
constexpr size_t W_wt_k = W_wt_r + AL((size_t)1024 * 1024 * 2);
constexpr size_t W_wt_v = W_wt_k + AL((size_t)1024 * 1024 * 2);
constexpr size_t W_wt_ro = W_wt_v + AL((size_t)1024 * 1024 * 2);
constexpr size_t W_wt_w1 = W_wt_ro + AL((size_t)1024 * 1024 * 2);
constexpr size_t W_wt_a1 = W_wt_w1 + AL((size_t)128 * 1024 * 2);
constexpr size_t W_wt_g1 = W_wt_a1 + AL((size_t)128 * 1024 * 2);
constexpr size_t W_wt_w2 = W_wt_g1 + AL((size_t)256 * 1024 * 2);
constexpr size_t W_wt_a2 = W_wt_w2 + AL((size_t)1024 * 64 * 2);
constexpr size_t W_wt_g2 = W_wt_a2 + AL((size_t)1024 * 64 * 2);
constexpr size_t W_wt_gu = W_wt_g2 + AL((size_t)1024 * 192 * 2);
constexpr size_t W_wt_down = W_wt_gu + AL((size_t)4 * 5632 * 1024 * 2);
constexpr size_t W_X = W_wt_down + AL((size_t)4 * 1024 * 2816 * 2);
constexpr size_t W_Z = W_X + AL((size_t)MP * 1024 * 4);
constexpr size_t W_Xb = W_Z + AL((size_t)MP * 1024 * 4);
constexpr size_t W_cs = W_Xb + AL((size_t)MP * 1024 * 2);
constexpr size_t W_ZT = W_cs + AL((size_t)MP * 64 * 4);
constexpr size_t W_arena = W_ZT + AL((size_t)384 * 1024 * 4);
constexpr size_t W_TOTAL = W_arena + AL(ARENA_BYTES);

DEVI int TID() { int t = threadIdx.x; asm volatile("" : "+v"(t)); return t; }
DEVI int BID() { int b = blockIdx.x; asm volatile("" : "+s"(b)); return b; }
typedef float f32x2 __attribute__((ext_vector_type(2)));
typedef __bf16 bf16x2v __attribute__((ext_vector_type(2)));
DEVI bf16 f2bf(float f) { __bf16 r = (__bf16)f; return __builtin_bit_cast(unsigned short, r); }
DEVI float bf2f(bf16 h) { return __uint_as_float(((unsigned)h) << 16); }
DEVI unsigned pack2(float a, float b) {
  f32x2 v = {a, b};
  bf16x2v r = __builtin_convertvector(v, bf16x2v);
  return __builtin_bit_cast(unsigned, r);
}
DEVI float bflo(unsigned u) { return __uint_as_float(u << 16); }
DEVI float bfhi(unsigned u) { return __uint_as_float(u & 0xffff0000u); }
DEVI float siluf(float x) { return x * __builtin_amdgcn_rcpf(1.f + __expf(-x)); }
DEVI float sigmf(float x) { return __builtin_amdgcn_rcpf(1.f + __expf(-x)); }
DEVI float softplusf(float x) { return x > 20.f ? x : __logf(1.f + __expf(x)); }
DEVI float tanhfast(float x) { return 1.f - 2.f / (__expf(2.f * x) + 1.f); }
DEVI float wave_sum(float v) {
#pragma unroll
  for (int d = 32; d >= 1; d >>= 1) v += __shfl_xor(v, d);
  return v;
}
DEVI f32x16 mfma32(bf16x8 a, bf16x8 b, f32x16 c) { return __builtin_amdgcn_mfma_f32_32x32x16_bf16(a, b, c, 0, 0, 0); }
DEVI f32x16 zero16() {
  f32x16 z;
#pragma unroll
  for (int i = 0; i < 16; ++i) z[i] = 0.f;
  return z;
}
DEVI int accrow(int r, int lane) { return (r & 3) + 8 * (r >> 2) + 4 * (lane >> 5); }

template <int CTRL, int RM>
DEVI float dpp_add(float x) {
  int y = __builtin_amdgcn_update_dpp(0, __float_as_int(x), CTRL, RM, 0xf, true);
  return x + __int_as_float(y);
}
DEVI float wave_sum63(float x) {
  x = dpp_add<0xB1, 0xf>(x);
  x = dpp_add<0x4E, 0xf>(x);
  x = dpp_add<0x141, 0xf>(x);
  x = dpp_add<0x140, 0xf>(x);
  x = dpp_add<0x142, 0xa>(x);
  x = dpp_add<0x143, 0xc>(x);
  return __int_as_float(__builtin_amdgcn_readlane(__float_as_int(x), 63));
}

DEVI f32x16 mma_lds(const bf16* As, int lda, const bf16* Bs, int ldb, int K, f32x16 acc, int lane) {
  const bf16* ap = As + (lane & 31) * lda + (lane >> 5) * 8;
  const bf16* bp = Bs + (lane & 31) * ldb + (lane >> 5) * 8;
#pragma unroll 4
  for (int k = 0; k < K; k += 16) {
    acc = mfma32(*(const bf16x8*)(ap + k), *(const bf16x8*)(bp + k), acc);
    if ((k & 48) == 48) __builtin_amdgcn_sched_barrier(0);
  }
  return acc;
}


constexpr int GB_XCNT = 128, GB_XARR = 1280, GB_TOP = 2432, GB_TOPGEN = 2496, GB_XGEN = 2560;
DEVI unsigned ld_agent(unsigned* q) { return __hip_atomic_load(q, __ATOMIC_RELAXED, __HIP_MEMORY_SCOPE_AGENT); }
DEVI unsigned add_agent(unsigned* q, unsigned v) { return __hip_atomic_fetch_add(q, v, __ATOMIC_RELAXED, __HIP_MEMORY_SCOPE_AGENT); }
DEVI unsigned xcc_id() { return (unsigned)__builtin_amdgcn_s_getreg((3 << 11) | 20) & 0xFu; }
DEVI void gb_spin(unsigned* q, unsigned g) {
  unsigned sp = 0;
  while (ld_agent(q) < g) {
    __builtin_amdgcn_s_sleep(1);
    if (++sp > (1u << 22)) break;
  }
}
DEVI void gbar(unsigned* w, unsigned x, unsigned ncnt, unsigned nx, unsigned g) {
  asm volatile("s_waitcnt vmcnt(0) lgkmcnt(0)" ::: "memory");
  __syncthreads();
  if (threadIdx.x == 0) {
    const unsigned a = add_agent(&w[GB_XARR + 64 * x], 1u) + 1u;
    if (a == g * ncnt) {
      __builtin_amdgcn_fence(__ATOMIC_RELEASE, "agent");
      asm volatile("s_waitcnt vmcnt(0)" ::: "memory");
      const unsigned t = add_agent(&w[GB_TOP], 1u) + 1u;
      if (t == g * nx) __hip_atomic_store(&w[GB_TOPGEN], g, __ATOMIC_RELAXED, __HIP_MEMORY_SCOPE_AGENT);
      else gb_spin(&w[GB_TOPGEN], g);
      __builtin_amdgcn_fence(__ATOMIC_ACQUIRE, "agent");
      __hip_atomic_store(&w[GB_XGEN + 64 * x], g, __ATOMIC_RELAXED, __HIP_MEMORY_SCOPE_AGENT);
      asm volatile("s_waitcnt vmcnt(0)" ::: "memory");
    } else {
      gb_spin(&w[GB_XGEN + 64 * x], g);
      __builtin_amdgcn_fence(__ATOMIC_ACQUIRE, "agent");
      asm volatile("s_waitcnt vmcnt(0)" ::: "memory");
    }
  }
  __syncthreads();
}

enum {
  EPI_SSD_IN = 0, EPI_RESID, EPI_GU, EPI_QKV, EPI_F32, EPI_RK_W1, EPI_RK_A1, EPI_RK_G1, EPI_RK_W2, EPI_RK_A2, EPI_RESID_TAIL, EPI_BF16
};
struct GJob {
  const bf16* A;
  const bf16* Bt;
  int lda, K, epi, aux;
  float* of;
};

DEVI void gemm_epi_ssd_in(const Params& p, f32x16 (&acc)[2][2], int rbase, int cbase, int lane) {
  char* ar = PW(char, W_arena);
  const int d = lane & 31;
  if (cbase < 6144) {
    const bool isz = cbase < 2048;
    const int ld = isz ? 2048 : 4096;
    bf16* dst = (isz ? (bf16*)(ar + S_ZB) + cbase : (bf16*)(ar + S_XBC) + (cbase - 2048)) + d;
#pragma unroll
    for (int i = 0; i < 2; ++i)
#pragma unroll
      for (int r = 0; r < 16; ++r) {
        const int row = rbase + i * 32 + accrow(r, lane);
        if (row < M) {
          bf16* q = dst + (size_t)row * ld;
          q[0] = f2bf(acc[i][0][r]);
          q[32] = f2bf(acc[i][1][r]);
        }
      }
  } else {
    float* dtr = (float*)(ar + S_DTRAW);
#pragma unroll
    for (int i = 0; i < 2; ++i)
#pragma unroll
      for (int r = 0; r < 16; ++r) {
        const int row = rbase + i * 32 + accrow(r, lane);
        if (row < M && cbase == 6144) dtr[(size_t)row * 32 + d] = acc[i][0][r];
      }
  }
}

DEVI void gemm_epi_qkv(const Params& p, f32x16 (&acc)[2][2], int rbase, int cbase, int lane) {
  char* ar = PW(char, W_arena);
  const int which = cbase >> 10, cc = cbase & 1023, d = lane & 31, hl = lane >> 5;
#pragma unroll
  for (int i = 0; i < 2; ++i) {
#pragma unroll
    for (int rq = 0; rq < 4; ++rq) {
      const int row0 = rbase + i * 32 + 8 * rq + 4 * hl;
      if (row0 >= M) continue;
      const bool pr = row0 < TP;
      const int b = pr ? 0 : (row0 - TP) >> 4, t0 = pr ? row0 : (row0 - TP) & 15;
      if (which < 2) {
        const float* csp = PW(float, W_cs) + (size_t)row0 * 64 + d;
        bf16* dst;
        float* fo = nullptr;
        if (which == 0) dst = (bf16*)(ar + A_QB) + (size_t)row0 * 1024 + cc + d;
        else {
          const size_t ur = pr ? (size_t)(48 + row0) : (size_t)(LDVP + b * LDVS + 48 + 4096 + t0);
          dst = (bf16*)(ar + A_KALL) + ur * 1024 + cc + d;
          fo = (pr ? POUT + O_KP + (size_t)row0 * 1024 : POUT + O_KS + (size_t)(row0 - TP) * 1024) + cc + d;
        }
#pragma unroll
        for (int rr = 0; rr < 4; ++rr) {
          const float x1 = acc[i][0][rq * 4 + rr], x2 = acc[i][1][rq * 4 + rr];
          const float c = csp[rr * 64], s = csp[rr * 64 + 32];
          const float o1 = x1 * c - x2 * s, o2 = x2 * c + x1 * s;
          dst[rr * 1024] = f2bf(o1);
          dst[rr * 1024 + 32] = f2bf(o2);
          if (which == 1) { fo[rr * 1024] = o1; fo[rr * 1024 + 32] = o2; }
        }
      } else {
        float* vo = (pr ? POUT + O_VP + (size_t)row0 * 1024 : POUT + O_VS + (size_t)(row0 - TP) * 1024) + cc + d;
#pragma unroll
        for (int rr = 0; rr < 4; ++rr) {
          vo[rr * 1024] = acc[i][0][rq * 4 + rr];
          vo[rr * 1024 + 32] = acc[i][1][rq * 4 + rr];
        }
        const int h = cc >> 7, e = (cc & 127) + d;
        bf16* vt = pr ? (bf16*)(ar + A_VTP) + (size_t)(h * 128 + e) * LDVP + 48 + row0
                      : (bf16*)(ar + A_VTS) + (size_t)((b * 8 + h) * 128 + e) * LDVS + 48 + 4096 + t0;
        const size_t ld = pr ? LDVP : LDVS;
        uint2 o1, o2;
        o1.x = pack2(acc[i][0][rq * 4 + 0], acc[i][0][rq * 4 + 1]); o1.y = pack2(acc[i][0][rq * 4 + 2], acc[i][0][rq * 4 + 3]);
        o2.x = pack2(acc[i][1][rq * 4 + 0], acc[i][1][rq * 4 + 1]); o2.y = pack2(acc[i][1][rq * 4 + 2], acc[i][1][rq * 4 + 3]);
        *(uint2*)vt = o1;
        *(uint2*)(vt + 32 * ld) = o2;
      }
    }
  }
}

template <int EPI>
DEVI void gemm_epi(const Params& p, const GJob& jb, f32x16 (&acc)[2][2], int rbase, int cbase, int lane) {
  const float* i_rk_w0 = PIN(23);
  const float* i_rk_a0 = PIN(26);
  char* ar = PW(char, W_arena);
#pragma unroll
  for (int i = 0; i < 2; ++i) {
#pragma unroll
    for (int r = 0; r < 16; ++r) {
      const int row = rbase + i * 32 + accrow(r, lane);
      if (row < M) {
#pragma unroll
        for (int j = 0; j < 2; ++j) {
          const int col = cbase + j * 32 + (lane & 31);
          const float v = acc[i][j][r];
          if (EPI == EPI_SSD_IN) {
            if (col < 2048) ((bf16*)(ar + S_ZB))[(size_t)row * 2048 + col] = f2bf(v);
            else if (col < 6144) ((bf16*)(ar + S_XBC))[(size_t)row * 4096 + col - 2048] = f2bf(v);
            else if (col < 6176) ((float*)(ar + S_DTRAW))[(size_t)row * 32 + col - 6144] = v;
          } else if (EPI == EPI_RESID) {
            PW(bf16, W_Z)[(size_t)row * 1024 + col] = f2bf(ALPHA * bf2f(PW(bf16, W_Xb)[(size_t)row * 1024 + col]) + v);
          } else if (EPI == EPI_GU) {
            ((bf16*)(ar + F_GU))[(size_t)row * 5632 + col] = f2bf(v);
          } else if (EPI == EPI_BF16) {
            ((bf16*)jb.of)[(size_t)row * 1024 + col] = f2bf(v);
          } else if (EPI == EPI_F32) {
            jb.of[(size_t)row * 1024 + col] = v;
          } else if (EPI == EPI_RK_W1) {
            if (col < 64) ((bf16*)(ar + R_HW))[(size_t)row * 64 + col] = f2bf(tanhfast(v));
          } else if (EPI == EPI_RK_A1) {
            if (col < 64) ((bf16*)(ar + R_HA))[(size_t)row * 64 + col] = f2bf(v);
          } else if (EPI == EPI_RK_G1) {
            if (col < 192) ((bf16*)(ar + R_HG))[(size_t)row * 192 + col] = f2bf(col < 160 ? sigmf(v) : 0.f);
          } else if (EPI == EPI_RK_W2) {
            const float z = i_rk_w0[col] + v;
            const float wl = -softplusf(-z) - 0.5f;
            ((float*)(ar + R_W))[(size_t)row * 1024 + col] = __expf(-__expf(wl));
          } else if (EPI == EPI_RESID_TAIL) {
            atomicAdd(PW(float, W_ZT) + (size_t)(row - 16384) * 1024 + col, v);
          } else if (EPI == EPI_RK_A2) {
            ((bf16*)(ar + R_A))[(size_t)row * 1024 + col] = f2bf(sigmf(i_rk_a0[col] + v));
          }
        }
      }
    }
  }
}

DEVI void gemm_epi_gu(const Params& p, const GJob& jb, f32x16 (&acc)[2][2], int m0, int cbase, int wm, int wn, int lane, char* smem) {
  const float* i_state_ffn_conv = PIN(8);
  const float* i_ffn_conv_w = PIN(42);
  const float* i_ffn_conv_b = PIN(43);
  const int layer = jb.aux;
  float* Gs = (float*)smem;
  const int col = wn * 32 + (lane & 31);
#pragma unroll
  for (int i = 0; i < 2; ++i)
#pragma unroll
    for (int r = 0; r < 16; ++r) Gs[(wm * 64 + i * 32 + accrow(r, lane)) * 64 + col] = acc[i][0][r];
  __syncthreads();
  const int c = (cbase >> 6) * 32 + (lane & 31);
  const float w0 = i_ffn_conv_w[(size_t)layer * 3 * 2816 + c], w1 = i_ffn_conv_w[(size_t)layer * 3 * 2816 + 2816 + c];
  const float w2 = i_ffn_conv_w[(size_t)layer * 3 * 2816 + 2 * 2816 + c], cb = i_ffn_conv_b[(size_t)layer * 2816 + c];
  bf16* Hb = (bf16*)(PW(char, W_arena) + F_HB);
  float* outp = POUT;
  if (m0 >= 0 && m0 + 128 <= TP - 2) {
    bf16* hrow = Hb + (size_t)m0 * 2816 + c;
#pragma unroll
    for (int i = 0; i < 2; ++i) {
#pragma unroll
      for (int r = 0; r < 16; ++r) {
        const int trow = wm * 64 + i * 32 + accrow(r, lane);
        if (trow >= 2) {
          const float cv = cb + w0 * Gs[(trow - 2) * 64 + col] + w1 * Gs[(trow - 1) * 64 + col] + w2 * acc[i][0][r];
          hrow[(size_t)trow * 2816] = f2bf(siluf(cv) * acc[i][1][r]);
        }
      }
    }
    __syncthreads();
    return;
  }
#pragma unroll
  for (int i = 0; i < 2; ++i) {
#pragma unroll
    for (int r = 0; r < 16; ++r) {
      const int trow = wm * 64 + i * 32 + accrow(r, lane);
      const int m = m0 + trow;
      if (trow >= 2 && m < M) {
        int b = -1, t = m, L = TP;
        if (m >= TP) { b = (m - TP) >> 4; t = (m - TP) & 15; L = 16; }
        const float g2 = acc[i][0][r];
        float g1, g0;
        if (t >= 1) g1 = Gs[(trow - 1) * 64 + col];
        else g1 = (b >= 0) ? i_state_ffn_conv[((size_t)(layer * 16 + b) * 2 + 1) * 2816 + c] : 0.f;
        if (t >= 2) g0 = Gs[(trow - 2) * 64 + col];
        else g0 = (b >= 0) ? i_state_ffn_conv[((size_t)(layer * 16 + b) * 2 + t) * 2816 + c] : 0.f;
        const float cv = cb + w0 * g0 + w1 * g1 + w2 * g2;
        Hb[(size_t)m * 2816 + c] = f2bf(siluf(cv) * acc[i][1][r]);
        if (t >= L - 2) {
          float* so = (b < 0) ? outp + O_FCP + ((size_t)layer * 2 + (t - (L - 2))) * 2816 + c
                              : outp + O_FCS + ((size_t)(layer * 16 + b) * 2 + (t - (L - 2))) * 2816 + c;
          *so = g2;
        }
      }
    }
  }
  __syncthreads();
}

DEVI void gemm_tile(const Params& p, const GJob& jb, int m0, int n0, char* smem, int kt0 = 0, int kt1 = -1) {
  bf16* As = (bf16*)smem;
  bf16* Bs = As + 128 * 72;
  const int tid = TID(), lane = tid & 63, wave = tid >> 6, wm = wave >> 1, wn = wave & 1;
  f32x16 acc[2][2];
#pragma unroll
  for (int i = 0; i < 2; ++i)
#pragma unroll
    for (int j = 0; j < 2; ++j) acc[i][j] = zero16();
  const int lrow = tid >> 3, lkc = (tid & 7) * 8;
  const bf16* Ag = jb.A + (size_t)max(m0 + lrow, 0) * jb.lda + lkc;
  const bf16* Ag1 = jb.A + (ptrdiff_t)(m0 + lrow) * jb.lda + lkc;
  const bf16* Bg = jb.Bt + (size_t)(n0 + lrow) * jb.K + lkc;
  const size_t astep = (size_t)32 * jb.lda, bstep = (size_t)32 * jb.K;
  if (kt1 < 0) kt1 = jb.K >> 6;
  const int nk = kt1 - kt0;
  Ag += (size_t)kt0 * 64; Ag1 += (size_t)kt0 * 64; Bg += (size_t)kt0 * 64;
  u32x4 ra0[4], rb0[4], ra1[4], rb1[4];
#define G_LOAD(RA, RB, kt_)                                                  \
  {                                                                          \
    _Pragma("unroll") for (int i = 0; i < 4; ++i) {                          \
      RA[i] = *(const u32x4*)((i == 0 ? Ag : Ag1) + i * astep + (size_t)(kt_) * 64); \
      RB[i] = *(const u32x4*)(Bg + i * bstep + (size_t)(kt_) * 64);          \
    }                                                                        \
  }
#define G_STORE(RA, RB, AS_, BS_)                                            \
  {                                                                          \
    _Pragma("unroll") for (int i = 0; i < 4; ++i) {                          \
      *(u32x4*)(AS_ + (lrow + 32 * i) * 72 + lkc) = RA[i];                   \
      *(u32x4*)(BS_ + (lrow + 32 * i) * 72 + lkc) = RB[i];                   \
    }                                                                        \
  }
#define G_COMPUTE(AS_, BS_)                                                                                     \
  {                                                                                                             \
    _Pragma("unroll") for (int ks = 0; ks < 4; ++ks) {                                                          \
      bf16x8 a[2], b[2];                                                                                        \
      _Pragma("unroll") for (int i = 0; i < 2; ++i)                                                             \
        a[i] = *(const bf16x8*)(AS_ + (wm * 64 + i * 32 + (lane & 31)) * 72 + ks * 16 + (lane >> 5) * 8);       \
      _Pragma("unroll") for (int j = 0; j < 2; ++j)                                                             \
        b[j] = *(const bf16x8*)(BS_ + (wn * 64 + j * 32 + (lane & 31)) * 72 + ks * 16 + (lane >> 5) * 8);       \
      _Pragma("unroll") for (int i = 0; i < 2; ++i)                                                             \
        _Pragma("unroll") for (int j = 0; j < 2; ++j) acc[i][j] = mfma32(a[i], b[j], acc[i][j]);                \
    }                                                                                                           \
  }
  bf16* As1 = As + 2 * 128 * 72;
  bf16* Bs1 = As1 + 128 * 72;
  G_LOAD(ra0, rb0, 0);
  if (nk > 1) G_LOAD(ra1, rb1, 1);
  G_STORE(ra0, rb0, As, Bs);
  __syncthreads();
  for (int kt = 0; kt < nk; kt += 2) {
    if (kt + 2 < nk) G_LOAD(ra0, rb0, kt + 2);
    if (kt + 1 < nk) G_STORE(ra1, rb1, As1, Bs1);
    G_COMPUTE(As, Bs);
    __syncthreads();
    if (kt + 1 < nk) {
      if (kt + 3 < nk) G_LOAD(ra1, rb1, kt + 3);
      if (kt + 2 < nk) G_STORE(ra0, rb0, As, Bs);
      G_COMPUTE(As1, Bs1);
      __syncthreads();
    }
  }
#undef G_LOAD
#undef G_STORE
#undef G_COMPUTE
  const int rbase = m0 + wm * 64, cbase = n0 + wn * 64;
  switch (jb.epi) {
    case EPI_SSD_IN: gemm_epi_ssd_in(p, acc, rbase, cbase, lane); break;
    case EPI_RESID: gemm_epi<EPI_RESID>(p, jb, acc, rbase, cbase, lane); break;
    case EPI_GU: gemm_epi_gu(p, jb, acc, m0, cbase, wm, wn, lane, smem); break;
    case EPI_QKV: gemm_epi_qkv(p, acc, rbase, cbase, lane); break;
    case EPI_F32: gemm_epi<EPI_F32>(p, jb, acc, rbase, cbase, lane); break;
    case EPI_BF16: gemm_epi<EPI_BF16>(p, jb, acc, rbase, cbase, lane); break;
    case EPI_RK_W1: gemm_epi<EPI_RK_W1>(p, jb, acc, rbase, cbase, lane); break;
    case EPI_RK_A1: gemm_epi<EPI_RK_A1>(p, jb, acc, rbase, cbase, lane); break;
    case EPI_RK_G1: gemm_epi<EPI_RK_G1>(p, jb, acc, rbase, cbase, lane); break;
    case EPI_RK_W2: gemm_epi<EPI_RK_W2>(p, jb, acc, rbase, cbase, lane); break;
    case EPI_RESID_TAIL: gemm_epi<EPI_RESID_TAIL>(p, jb, acc, rbase, cbase, lane); break;
    default: gemm_epi<EPI_RK_A2>(p, jb, acc, rbase, cbase, lane); break;
  }
}

DEVI void tile_decode(int id, int nttot, int& mt, int& ntg, int mtn = MT) {
  const int per = 16 * nttot;
  const int g = id / per, r = id - g * per;
  const int gsz = min(16, mtn - g * 16);
  mt = g * 16 + r % gsz;
  ntg = r / gsz;
}

DEVI void gemm_single(const Params& p, const GJob& jb, int nt, char* smem) {
  const bool fused = (jb.epi == EPI_GU);
  const int mtn = fused ? 133 : MT;
  if (nt >= 16 && (gridDim.x & 7) == 0) {
    const int b = BID(), x = b & 7, lb = b >> 3, nlb = gridDim.x >> 3;
    const int ng = x & 3, mh = x >> 2;
    const int n_lo = ng * nt / 4, nnt = (ng + 1) * nt / 4 - n_lo;
    const int m_lo = mh * mtn / 2, nmt = (mh + 1) * mtn / 2 - m_lo;
    for (int t = lb; t < nmt * nnt; t += nlb) {
      const int mt = m_lo + t / nnt, ntg = n_lo + t % nnt;
      gemm_tile(p, jb, fused ? mt * 126 - 2 : mt * 128, ntg * 128, smem);
    }
    return;
  }
  if (jb.epi == EPI_RESID && nt == 8) {
    for (int id = BID(); id < 1024; id += gridDim.x) {
      int mt, ntg;
      tile_decode(id, 8, mt, ntg, 128);
      gemm_tile(p, jb, mt * 128, ntg * 128, smem);
    }
    const int nkt = jb.K >> 6;
    const int S = max(1, min(nkt, (int)gridDim.x / 24));
    GJob jt = jb;
    jt.epi = EPI_RESID_TAIL;
    for (int u = BID(); u < 24 * S; u += gridDim.x) {
      const int tile = u / S, c = u - tile * S;
      gemm_tile(p, jt, (128 + (tile >> 3)) * 128, (tile & 7) * 128, smem, c * nkt / S, (c + 1) * nkt / S);
    }
    return;
  }
  const int total = mtn * nt;
  for (int id = BID(); id < total; id += gridDim.x) {
    int mt, ntg;
    tile_decode(id, nt, mt, ntg, mtn);
    gemm_tile(p, jb, fused ? mt * 126 - 2 : mt * 128, ntg * 128, smem);
  }
}

DEVI void tjob(const Params& p, int j, const float*& src, bf16*& dst, int& K, int& N, int& Kp, int& Np, int& rmap) {
  rmap = (j >= 16 && j < 20) ? 1 : (j >= 20 && j < 24) ? 2 : 0;
  const float* i_ssd_w_in = PIN(10);
  const float* i_ssd_w_out = PIN(17);
  const float* i_da_w_qkv = PIN(18);
  const float* i_da_w_o = PIN(21);
  const float* i_rk_w_r = PIN(34);
  const float* i_rk_w_k = PIN(35);
  const float* i_rk_w_v = PIN(36);
  const float* i_rk_w_o = PIN(37);
  const float* i_rk_w1 = PIN(24);
  const float* i_rk_a1 = PIN(27);
  const float* i_rk_g1 = PIN(29);
  const float* i_rk_w2 = PIN(25);
  const float* i_rk_a2 = PIN(28);
  const float* i_rk_g2 = PIN(30);
  const float* i_ffn_w_gate = PIN(41);
  const float* i_ffn_w_up = PIN(40);
  const float* i_ffn_w_down = PIN(44);
  if (j < 2) { src = i_ssd_w_in + (size_t)j * 1024 * 6176; dst = PW(bf16, W_wt_ssd_in) + (size_t)j * 6272 * 1024; K = 1024; N = 6176; Kp = 1024; Np = 6272; }
  else if (j < 4) { src = i_ssd_w_out + (size_t)(j - 2) * 2048 * 1024; dst = PW(bf16, W_wt_ssd_out) + (size_t)(j - 2) * 1024 * 2048; K = 2048; N = 1024; Kp = 2048; Np = 1024; }
  else if (j == 4) { src = i_da_w_qkv; dst = PW(bf16, W_wt_qkv); K = 1024; N = 3072; Kp = 1024; Np = 3072; }
  else if (j < 10) {
    K = 1024; N = 1024; Kp = 1024; Np = 1024;
    if (j == 5) { src = i_da_w_o; dst = PW(bf16, W_wt_o); }
    else if (j == 6) { src = i_rk_w_r; dst = PW(bf16, W_wt_r); }
    else if (j == 7) { src = i_rk_w_k; dst = PW(bf16, W_wt_k); }
    else if (j == 8) { src = i_rk_w_v; dst = PW(bf16, W_wt_v); }
    else { src = i_rk_w_o; dst = PW(bf16, W_wt_ro); }
  }
  else if (j == 10) { src = i_rk_w1; dst = PW(bf16, W_wt_w1); K = 1024; N = 64; Kp = 1024; Np = 128; }
  else if (j == 11) { src = i_rk_a1; dst = PW(bf16, W_wt_a1); K = 1024; N = 64; Kp = 1024; Np = 128; }
  else if (j == 12) { src = i_rk_g1; dst = PW(bf16, W_wt_g1); K = 1024; N = 160; Kp = 1024; Np = 256; }
  else if (j == 13) { src = i_rk_w2; dst = PW(bf16, W_wt_w2); K = 64; N = 1024; Kp = 64; Np = 1024; }
  else if (j == 14) { src = i_rk_a2; dst = PW(bf16, W_wt_a2); K = 64; N = 1024; Kp = 64; Np = 1024; }
  else if (j == 15) { src = i_rk_g2; dst = PW(bf16, W_wt_g2); K = 160; N = 1024; Kp = 192; Np = 1024; }
  else if (j < 20) { src = i_ffn_w_gate + (size_t)(j - 16) * 1024 * 2816; dst = PW(bf16, W_wt_gu) + (size_t)(j - 16) * 5632 * 1024; K = 1024; N = 2816; Kp = 1024; Np = 2816; }
  else if (j < 24) { src = i_ffn_w_up + (size_t)(j - 20) * 1024 * 2816; dst = PW(bf16, W_wt_gu) + (size_t)(j - 20) * 5632 * 1024; K = 1024; N = 2816; Kp = 1024; Np = 2816; }
  else { src = i_ffn_w_down + (size_t)(j - 24) * 2816 * 1024; dst = PW(bf16, W_wt_down) + (size_t)(j - 24) * 1024 * 2816; K = 2816; N = 1024; Kp = 2816; Np = 1024; }
}

DEVI int tjob_group(int j) {
  if (j == 1 || j == 3 || j == 18 || j == 19 || j == 22 || j == 23 || j == 26 || j == 27) return 2;
  if (j == 0 || j == 2 || j == 16 || j == 20 || j == 24) return 0;
  return 1;
}

DEVI void convert_weights(const Params& p, char* smem, int group, int vb, int nvb) {
  const int tid = TID();
  float* tile = (float*)smem;
  int base = 0;
  for (int j = 0; j < 28; ++j) {
    if (tjob_group(j) != group) continue;
    const float* src; bf16* dst; int K, N, Kp, Np, rmap;
    tjob(p, j, src, dst, K, N, Kp, Np, rmap);
    const int tn_n = Np >> 6, nt = (Kp >> 6) * tn_n;
    int first = (vb - base % nvb + nvb) % nvb;
    for (int t = first; t < nt; t += nvb) {
      const int tk = t / tn_n, tn = t - tk * tn_n;
      for (int e = tid; e < 4096; e += 256) {
        const int i = e >> 6, jj = e & 63, k = tk * 64 + i, n = tn * 64 + jj;
        tile[i * 65 + jj] = (k < K && n < N) ? src[(size_t)k * N + n] : 0.f;
      }
      __syncthreads();
      for (int e = tid; e < 2048; e += 256) {
        const int i = e >> 5, j2 = (e & 31) * 2;
        const unsigned v = pack2(tile[j2 * 65 + i], tile[(j2 + 1) * 65 + i]);
        const int nrow = tn * 64 + i;
        const int drow = (rmap == 0) ? nrow : ((nrow >> 5) * 64 + (nrow & 31) + (rmap == 2 ? 32 : 0));
        *(unsigned*)(dst + (size_t)drow * Kp + tk * 64 + j2) = v;
      }
      __syncthreads();
    }
    base += nt;
  }
}

DEVI void phase_prep(const Params& p, char* smem) {
  const float* i_meta = PIN(9);
  const float* i_x_prompt = PIN(0);
  const float* i_x_sample = PIN(1);
  const int tid = TID(), G = gridDim.x;
  const size_t gtid = (size_t)BID() * 256 + tid, nth = (size_t)G * 256;
  convert_weights(p, smem, 0, BID(), G);
  for (size_t i0 = gtid; i0 < (size_t)M * 256; i0 += nth * 4) {
    float4 v[4];
#pragma unroll
    for (int u = 0; u < 4; ++u) {
      const size_t idx = i0 + u * nth;
      if (idx < (size_t)M * 256) {
        const int m = (int)(idx >> 8), c4 = (int)(idx & 255) * 4;
        const float* src = (m < 16) ? i_meta + (size_t)m * 1024
                                    : (m < TP) ? i_x_prompt + (size_t)(m - 16) * 1024 : i_x_sample + (size_t)(m - TP) * 1024;
        v[u] = *(const float4*)(src + c4);
      }
    }
#pragma unroll
    for (int u = 0; u < 4; ++u) {
      const size_t idx = i0 + u * nth;
      if (idx < (size_t)M * 256) {
        const int m = (int)(idx >> 8), c4 = (int)(idx & 255) * 4;
        uint2 o; o.x = pack2(v[u].x, v[u].y); o.y = pack2(v[u].z, v[u].w);
        *(uint2*)(PW(bf16, W_Xb) + (size_t)m * 1024 + c4) = o;
      }
    }
  }
  for (size_t idx = gtid; idx < (size_t)384 * 256; idx += nth) *(float4*)(PW(float, W_ZT) + idx * 4) = make_float4(0.f, 0.f, 0.f, 0.f);
  for (size_t idx = gtid; idx < (size_t)M * 32; idx += nth) {
    const int m = (int)(idx >> 5), d = (int)(idx & 31);
    const float pos = (m < TP) ? (float)m : (float)(4096 + ((m - TP) & 15));
    const float inv = __builtin_amdgcn_exp2f(-(float)d * (13.287712379549449f / 32.f));
    float tr = (pos * inv) * 0.15915494309189535f;
    tr -= floorf(tr);
    PW(float, W_cs)[(size_t)m * 64 + d] = __builtin_amdgcn_cosf(tr);
    PW(float, W_cs)[(size_t)m * 64 + 32 + d] = __builtin_amdgcn_sinf(tr);
  }
}

DEVI void phase_ln(const Params& p, int li, bool final_) {
  const float* i_ln_g = PIN(45);
  const float* i_ln_b = PIN(46);
  const int lane = TID() & 63;
  const int gw = BID() * 4 + (TID() >> 6), nw = gridDim.x * 4;
  const float* g = i_ln_g + (size_t)li * 1024;
  const float* b = i_ln_b + (size_t)li * 1024;
  float4 ggr[4], bbr[4];
#pragma unroll
  for (int i = 0; i < 4; ++i) {
    ggr[i] = *(const float4*)(g + (i * 64 + lane) * 4);
    bbr[i] = *(const float4*)(b + (i * 64 + lane) * 4);
  }
  for (int m = gw; m < M; m += nw) {
    const bf16* z = PW(bf16, W_Z) + (size_t)m * 1024;
    f32x4 v[4];
    float s = 0.f;
    if (m < 16384) {
#pragma unroll
      for (int i = 0; i < 4; ++i) {
        const uint2 zz = *(const uint2*)(z + (i * 64 + lane) * 4);
        v[i] = f32x4{bflo(zz.x), bfhi(zz.x), bflo(zz.y), bfhi(zz.y)};
      }
    } else {
      float* zt = PW(float, W_ZT) + (size_t)(m - 16384) * 1024;
      const bf16* xo = PW(bf16, W_Xb) + (size_t)m * 1024;
#pragma unroll
      for (int i = 0; i < 4; ++i) {
        const int c = (i * 64 + lane) * 4;
        const uint2 xx = *(const uint2*)(xo + c);
        const f32x4 t = *(const f32x4*)(zt + c);
        v[i] = f32x4{ALPHA * bflo(xx.x) + t.x, ALPHA * bfhi(xx.x) + t.y, ALPHA * bflo(xx.y) + t.z, ALPHA * bfhi(xx.y) + t.w};
        *(f32x4*)(zt + c) = f32x4{0.f, 0.f, 0.f, 0.f};
      }
    }
#pragma unroll
    for (int i = 0; i < 4; ++i) s += v[i].x + v[i].y + v[i].z + v[i].w;
    const float mean = wave_sum(s) * (1.f / 1024.f);
    float q = 0.f;
#pragma unroll
    for (int i = 0; i < 4; ++i) {
      v[i].x -= mean; v[i].y -= mean; v[i].z -= mean; v[i].w -= mean;
      q += v[i].x * v[i].x + v[i].y * v[i].y + v[i].z * v[i].z + v[i].w * v[i].w;
    }
    const float rstd = rsqrtf(wave_sum(q) * (1.f / 1024.f) + 1e-5f);
#pragma unroll
    for (int i = 0; i < 4; ++i) {
      const int c = (i * 64 + lane) * 4;
      const float4 gg = ggr[i], bb = bbr[i];
      float4 o;
      o.x = v[i].x * rstd * gg.x + bb.x; o.y = v[i].y * rstd * gg.y + bb.y;
      o.z = v[i].z * rstd * gg.z + bb.z; o.w = v[i].w * rstd * gg.w + bb.w;
      uint2 ob; ob.x = pack2(o.x, o.y); ob.y = pack2(o.z, o.w);
      *(uint2*)(PW(bf16, W_Xb) + (size_t)m * 1024 + c) = ob;
      if (final_) {
        if (m >= TP) *(float4*)(POUT + O_YS + (size_t)(m - TP) * 1024 + c) = o;
        else if (m >= 16) *(float4*)(POUT + O_YP + (size_t)(m - 16) * 1024 + c) = o;
      }
    }
  }
}

DEVI void phase_ffn_e(const Params& p, int layer) {
  const float* i_state_ffn_conv = PIN(8);
  const float* i_ffn_conv_w = PIN(42);
  const float* i_ffn_conv_b = PIN(43);
  const size_t gtid = (size_t)BID() * 256 + TID(), nth = (size_t)gridDim.x * 256;
  const bf16* GU = (const bf16*)(PW(char, W_arena) + F_GU);
  bf16* Hb = (bf16*)(PW(char, W_arena) + F_HB);
  float* outp = POUT;
  const float* cw = i_ffn_conv_w + (size_t)layer * 3 * 2816;
  const float* cb = i_ffn_conv_b + (size_t)layer * 2816;
  for (size_t idx = gtid; idx < (size_t)(M / 16) * 352; idx += nth) {
    const int rb = (int)(idx / 352), c = (int)(idx - (size_t)rb * 352) * 8;
    const int m0 = rb * 16;
    int b = -1, t0 = m0, L = TP;
    if (m0 >= TP) { b = (m0 - TP) >> 4; t0 = 0; L = 16; }
    float w0[8], w1[8], w2[8], bb[8], x0[8], x1[8];
#pragma unroll
    for (int e = 0; e < 8; ++e) {
      w0[e] = cw[c + e]; w1[e] = cw[2816 + c + e]; w2[e] = cw[2 * 2816 + c + e]; bb[e] = cb[c + e];
    }
    if (t0 >= 2) {
      const uint4 g0 = *(const uint4*)(GU + (size_t)(m0 - 2) * 5632 + c);
      const uint4 g1 = *(const uint4*)(GU + (size_t)(m0 - 1) * 5632 + c);
      x0[0] = bflo(g0.x); x0[1] = bfhi(g0.x); x0[2] = bflo(g0.y); x0[3] = bfhi(g0.y);
      x0[4] = bflo(g0.z); x0[5] = bfhi(g0.z); x0[6] = bflo(g0.w); x0[7] = bfhi(g0.w);
      x1[0] = bflo(g1.x); x1[1] = bfhi(g1.x); x1[2] = bflo(g1.y); x1[3] = bfhi(g1.y);
      x1[4] = bflo(g1.z); x1[5] = bfhi(g1.z); x1[6] = bflo(g1.w); x1[7] = bfhi(g1.w);
    } else {
#pragma unroll
      for (int e = 0; e < 8; ++e) {
        x0[e] = (b >= 0) ? i_state_ffn_conv[((size_t)(layer * 16 + b) * 2 + 0) * 2816 + c + e] : 0.f;
        x1[e] = (b >= 0) ? i_state_ffn_conv[((size_t)(layer * 16 + b) * 2 + 1) * 2816 + c + e] : 0.f;
      }
    }
    u32x4 gq[16], uq[16];
#pragma unroll
    for (int r = 0; r < 16; ++r) {
      gq[r] = *(const u32x4*)(GU + (size_t)(m0 + r) * 5632 + c);
      uq[r] = *(const u32x4*)(GU + (size_t)(m0 + r) * 5632 + 2816 + c);
    }
#pragma unroll
    for (int r = 0; r < 16; ++r) {
      float x2[8], u[8], h[8];
#pragma unroll
      for (int e = 0; e < 4; ++e) {
        x2[2 * e] = bflo(gq[r][e]); x2[2 * e + 1] = bfhi(gq[r][e]);
        u[2 * e] = bflo(uq[r][e]); u[2 * e + 1] = bfhi(uq[r][e]);
      }
#pragma unroll
      for (int e = 0; e < 8; ++e) {
        const float cv = bb[e] + w0[e] * x0[e] + w1[e] * x1[e] + w2[e] * x2[e];
        h[e] = siluf(cv) * u[e];
      }
      uint4 o;
      o.x = pack2(h[0], h[1]); o.y = pack2(h[2], h[3]); o.z = pack2(h[4], h[5]); o.w = pack2(h[6], h[7]);
      *(uint4*)(Hb + (size_t)(m0 + r) * 2816 + c) = o;
      const int t = t0 + r;
      if (t >= L - 2) {
        float* so = (b < 0) ? outp + O_FCP + ((size_t)layer * 2 + (t - (L - 2))) * 2816 + c
                            : outp + O_FCS + ((size_t)(layer * 16 + b) * 2 + (t - (L - 2))) * 2816 + c;
#pragma unroll
        for (int e = 0; e < 8; ++e) so[e] = x2[e];
      }
#pragma unroll
      for (int e = 0; e < 8; ++e) { x0[e] = x1[e]; x1[e] = x2[e]; }
    }
  }
}

DEVI void chunk_rows(int ci, int& r0, int& nv) {
  if (ci < 257) { r0 = ci * 64; nv = (ci == 256) ? 16 : 64; }
  else { r0 = TP + (ci - 257) * 16; nv = 16; }
}

DEVI void phase_ssd_e1(const Params& p, int jl, char* smem) {
  const float* i_ssd_conv_w = PIN(11);
  const float* i_ssd_conv_b = PIN(12);
  const float* i_state_ssd_conv = PIN(5);
  const float* i_ssd_dt_bias = PIN(13);
  char* ar = PW(char, W_arena);
  const bf16* xbc = (const bf16*)(ar + S_XBC);
  bf16* xc = (bf16*)(ar + S_XC);
  bf16* xT = (bf16*)(ar + S_XT);
  bf16* BT = (bf16*)(ar + S_BT);
  const float* cw = i_ssd_conv_w + (size_t)jl * 4 * 4096;
  const float* cbias = i_ssd_conv_b + (size_t)jl * 4096;
  bf16* T = (bf16*)smem;
  const int tid = TID();
  float wgt[4][16], bia[16];
  int cbw = -1;
  for (int tl = BID(); tl < NCH * 64; tl += gridDim.x) {
    const int ci = tl >> 6, cb = tl & 63;
    int r0, nv;
    chunk_rows(ci, r0, nv);
    const int l = tid >> 2, cq = (tid & 3) * 16;
    const int c0 = cb * 64 + cq;
    if (cb != cbw) {
      cbw = cb;
#pragma unroll
      for (int e = 0; e < 16; ++e) {
        bia[e] = cbias[c0 + e];
#pragma unroll
        for (int j = 0; j < 4; ++j) wgt[j][e] = cw[(size_t)j * 4096 + c0 + e];
      }
    }
    const int m = r0 + l;
    const bool valid = l < nv;
    const int b = (ci >= 257) ? ci - 257 : -1;
    const int t = (b >= 0) ? l : m;
    float o[16];
#pragma unroll
    for (int e = 0; e < 16; ++e) o[e] = 0.f;
    if (valid) {
#pragma unroll
      for (int e = 0; e < 16; ++e) o[e] = bia[e];
#pragma unroll
      for (int j = 0; j < 4; ++j) {
        const int tt = t - 3 + j;
        float xv[16];
        if (tt >= 0) {
          const uint4 a0 = *(const uint4*)(xbc + (size_t)(m - 3 + j) * 4096 + c0);
          const uint4 a1 = *(const uint4*)(xbc + (size_t)(m - 3 + j) * 4096 + c0 + 8);
          const unsigned a[8] = {a0.x, a0.y, a0.z, a0.w, a1.x, a1.y, a1.z, a1.w};
#pragma unroll
          for (int e = 0; e < 8; ++e) { xv[2 * e] = bflo(a[e]); xv[2 * e + 1] = bfhi(a[e]); }
        } else {
#pragma unroll
          for (int e = 0; e < 16; ++e)
            xv[e] = (b >= 0) ? i_state_ssd_conv[((size_t)(jl * 16 + b) * 3 + (tt + 3)) * 4096 + c0 + e] : 0.f;
        }
#pragma unroll
        for (int e = 0; e < 16; ++e) o[e] += wgt[j][e] * xv[e];
        if (j == 3 && ci >= 256 && l >= 13) {
          float* so = (b < 0) ? POUT + O_SCP + ((size_t)jl * 3 + (l - 13)) * 4096 + c0
                              : POUT + O_SCS + ((size_t)(jl * 16 + b) * 3 + (l - 13)) * 4096 + c0;
#pragma unroll
          for (int e = 0; e < 16; ++e) so[e] = xv[e];
        }
      }
#pragma unroll
      for (int e = 0; e < 16; ++e) o[e] = siluf(o[e]);
      uint4 w0, w1;
      w0.x = pack2(o[0], o[1]); w0.y = pack2(o[2], o[3]); w0.z = pack2(o[4], o[5]); w0.w = pack2(o[6], o[7]);
      w1.x = pack2(o[8], o[9]); w1.y = pack2(o[10], o[11]); w1.z = pack2(o[12], o[13]); w1.w = pack2(o[14], o[15]);
      *(uint4*)(xc + (size_t)m * 4096 + c0) = w0;
      *(uint4*)(xc + (size_t)m * 4096 + c0 + 8) = w1;
    }
    if (cb < 48) {
#pragma unroll
      for (int e = 0; e < 16; ++e) T[(cq + e) * 72 + l] = f2bf(o[e]);
      __syncthreads();
      const int cl = tid >> 2, lq = (tid & 3) * 16;
      const uint4 v0 = *(const uint4*)(T + cl * 72 + lq);
      const uint4 v1 = *(const uint4*)(T + cl * 72 + lq + 8);
      bf16* dst = (cb < 32) ? xT + ((size_t)ci * 2048 + cb * 64 + cl) * 64 + lq
                            : BT + ((size_t)ci * 1024 + (cb - 32) * 64 + cl) * 64 + lq;
      *(uint4*)dst = v0;
      *(uint4*)(dst + 8) = v1;
      __syncthreads();
    }
  }
  const float* dtraw = (const float*)(ar + S_DTRAW);
  float* dt = (float*)(ar + S_DT);
  for (size_t idx = (size_t)BID() * 256 + tid; idx < (size_t)M * 32; idx += (size_t)gridDim.x * 256)
    dt[idx] = softplusf(dtraw[idx] + i_ssd_dt_bias[jl * 32 + (idx & 31)]);
}

DEVI void ssd_chunk_scan(const Params& p, int jl, int g, int r0, int nv, float* acsS, float* dtS) {
  const float* i_ssd_a_log = PIN(14);
  const int lane = TID() & 63, w = TID() >> 6;
  const int h = g * 4 + w;
  const float* dt = (const float*)(PW(char, W_arena) + S_DT);
  const float a = -__expf(i_ssd_a_log[jl * 32 + h]);
  const float dtv = (lane < nv) ? dt[(size_t)(r0 + lane) * 32 + h] : 0.f;
  float v = dtv * a;
#pragma unroll
  for (int d = 1; d < 64; d <<= 1) {
    const float tv = __shfl_up(v, d);
    if (lane >= d) v += tv;
  }
  acsS[w * 64 + lane] = v;
  dtS[w * 64 + lane] = dtv;
}

DEVI void phase_ssd_a(const Params& p, int jl, char* smem) {
  char* ar = PW(char, W_arena);
  const bf16* xT = (const bf16*)(ar + S_XT);
  const bf16* BT = (const bf16*)(ar + S_BT);
  bf16* CS = (bf16*)(ar + S_CS);
  float* CD = (float*)(ar + S_CD);
  bf16* Bs = (bf16*)smem;
  bf16* As = Bs + 128 * 72;
  float* acsS = (float*)(As + 64 * 72);
  float* dtS = acsS + 256;
  const int tid = TID(), lane = tid & 63, wave = tid >> 6;
  for (int tl = BID(); tl < NCH * 8; tl += gridDim.x) {
    const int ci = tl >> 3, g = tl & 7;
    int r0, nv;
    chunk_rows(ci, r0, nv);
    ssd_chunk_scan(p, jl, g, r0, nv, acsS, dtS);
#pragma unroll
    for (int i = 0; i < 4; ++i) {
      const int id = tid + 256 * i, n = id >> 3, kc = (id & 7) * 8;
      *(uint4*)(Bs + n * 72 + kc) = *(const uint4*)(BT + ((size_t)ci * 1024 + g * 128 + n) * 64 + kc);
    }
    __syncthreads();
    if (lane == 63) CD[ci * 32 + g * 4 + wave] = __expf(acsS[wave * 64 + 63]);
#pragma unroll 1
    for (int hh = 0; hh < 4; ++hh) {
      const int h = g * 4 + hh;
      {
        const int pr = tid >> 2, lq = (tid & 3) * 16;
        const bf16* src = xT + ((size_t)ci * 2048 + h * 64 + pr) * 64 + lq;
        const uint4 a0 = *(const uint4*)src, a1 = *(const uint4*)(src + 8);
        const unsigned a[8] = {a0.x, a0.y, a0.z, a0.w, a1.x, a1.y, a1.z, a1.w};
        const float aend = acsS[hh * 64 + 63];
        unsigned o[8];
#pragma unroll
        for (int e = 0; e < 8; ++e) {
          const int l0 = lq + 2 * e;
          const float w0 = dtS[hh * 64 + l0] * __expf(aend - acsS[hh * 64 + l0]);
          const float w1 = dtS[hh * 64 + l0 + 1] * __expf(aend - acsS[hh * 64 + l0 + 1]);
          o[e] = pack2(bflo(a[e]) * w0, bfhi(a[e]) * w1);
        }
        uint4 q0, q1;
        q0.x = o[0]; q0.y = o[1]; q0.z = o[2]; q0.w = o[3]; q1.x = o[4]; q1.y = o[5]; q1.z = o[6]; q1.w = o[7];
        *(uint4*)(As + pr * 72 + lq) = q0;
        *(uint4*)(As + pr * 72 + lq + 8) = q1;
      }
      __syncthreads();
      const int wp = wave >> 1, wn = wave & 1;
#pragma unroll
      for (int j = 0; j < 2; ++j) {
        f32x16 acc = zero16();
        acc = mma_lds(As + (wp * 32) * 72, 72, Bs + (wn * 64 + j * 32) * 72, 72, 64, acc, lane);
        bf16* dst = CS + ((size_t)(ci * 32 + h) * 64) * 128;
#pragma unroll
        for (int r = 0; r < 16; ++r) {
          const int pp = wp * 32 + accrow(r, lane), n = wn * 64 + j * 32 + (lane & 31);
          dst[pp * 128 + n] = f2bf(acc[r]);
        }
      }
      __syncthreads();
    }
  }
}

DEVI void phase_ssd_b(const Params& p, int jl, char* smem) {
  const float* i_state_ssm = PIN(4);
  char* ar = PW(char, W_arena);
  bf16* CS = (bf16*)(ar + S_CS);
  const float* CD = (const float*)(ar + S_CD);
  float* outp = POUT;
  const size_t gtid = (size_t)BID() * 256 + TID(), nth = (size_t)gridDim.x * 256;
  for (size_t it = gtid; it < (size_t)17 * 65536; it += nth) {
    const int seq = (int)(it >> 16), e4 = (int)(it & 65535) * 4;
    const int h = e4 >> 13;
    if (seq == 0) {
      float s0 = 0.f, s1 = 0.f, s2 = 0.f, s3 = 0.f;
      for (int c0 = 0; c0 < 257; c0 += 16) {
        uint2 cv[16];
        float cd[16];
#pragma unroll
        for (int u = 0; u < 16; ++u) {
          const int ci = min(c0 + u, 256);
          cv[u] = *(const uint2*)(CS + (size_t)ci * 262144 + e4);
          cd[u] = CD[ci * 32 + h];
        }
#pragma unroll
        for (int u = 0; u < 16; ++u) {
          if (c0 + u < 257) {
            uint2 o;
            o.x = pack2(s0, s1); o.y = pack2(s2, s3);
            *(uint2*)(CS + (size_t)(c0 + u) * 262144 + e4) = o;
            s0 = s0 * cd[u] + bflo(cv[u].x); s1 = s1 * cd[u] + bfhi(cv[u].x);
            s2 = s2 * cd[u] + bflo(cv[u].y); s3 = s3 * cd[u] + bfhi(cv[u].y);
          }
        }
      }
      *(float4*)(outp + O_SSMP + (size_t)jl * 262144 + e4) = make_float4(s0, s1, s2, s3);
    } else {
      const int b = seq - 1, ci = 257 + b;
      const float4 sa = *(const float4*)(i_state_ssm + ((size_t)(jl * 16 + b)) * 262144 + e4);
      const uint2 cv = *(const uint2*)(CS + (size_t)ci * 262144 + e4);
      const float cd = CD[ci * 32 + h];
      uint2 o;
      o.x = pack2(sa.x, sa.y); o.y = pack2(sa.z, sa.w);
      *(uint2*)(CS + (size_t)ci * 262144 + e4) = o;
      *(float4*)(outp + O_SSMS + ((size_t)(jl * 16 + b)) * 262144 + e4) =
          make_float4(sa.x * cd + bflo(cv.x), sa.y * cd + bfhi(cv.x), sa.z * cd + bflo(cv.y), sa.w * cd + bfhi(cv.y));
    }
  }
  if (jl == 0 && BID() >= 256 && gridDim.x > 256) convert_weights(p, smem, 1, BID() - 256, gridDim.x - 256);
}

DEVI void phase_ssd_c(const Params& p, int jl, char* smem) {
  const float* i_ssd_d = PIN(15);
  char* ar = PW(char, W_arena);
  const bf16* xc = (const bf16*)(ar + S_XC);
  const bf16* xT = (const bf16*)(ar + S_XT);
  const bf16* CS = (const bf16*)(ar + S_CS);
  bf16* ys = (bf16*)(ar + S_YS);
  bf16* Cs = (bf16*)smem;
  bf16* Bs = Cs + 64 * 136;
  bf16* Gs = Bs + 64 * 136;
  bf16* Xs = Gs + 64 * 72;
  float* acsS = (float*)(Xs + 64 * 72);
  float* dtS = acsS + 256;
  const int tid = TID(), lane = tid & 63, wave = tid >> 6;
  const int wl = wave >> 1, w2 = wave & 1;
  for (int tl = BID(); tl < NCH * 8; tl += gridDim.x) {
    const int ci = tl >> 3, g = tl & 7;
    int r0, nv;
    chunk_rows(ci, r0, nv);
    ssd_chunk_scan(p, jl, g, r0, nv, acsS, dtS);
#pragma unroll
    for (int i = 0; i < 4; ++i) {
      const int id = tid + 256 * i, l = id >> 4, kc = (id & 15) * 8;
      uint4 cvv = make_uint4(0, 0, 0, 0), bvv = make_uint4(0, 0, 0, 0);
      if (l < nv) {
        cvv = *(const uint4*)(xc + (size_t)(r0 + l) * 4096 + 3072 + g * 128 + kc);
        bvv = *(const uint4*)(xc + (size_t)(r0 + l) * 4096 + 2048 + g * 128 + kc);
      }
      *(uint4*)(Cs + l * 136 + kc) = cvv;
      *(uint4*)(Bs + l * 136 + kc) = bvv;
    }
    __syncthreads();
    f32x16 cb = zero16();
    cb = mma_lds(Cs + (wl * 32) * 136, 136, Bs + (w2 * 32) * 136, 136, 128, cb, lane);
    __syncthreads();
#pragma unroll 1
    for (int hh = 0; hh < 4; ++hh) {
      const int h = g * 4 + hh;
      {
        const int s = w2 * 32 + (lane & 31);
        const float as = acsS[hh * 64 + s], ds = dtS[hh * 64 + s];
#pragma unroll
        for (int r = 0; r < 16; ++r) {
          const int l = wl * 32 + accrow(r, lane);
          const float gv = (s <= l) ? cb[r] * __expf(acsS[hh * 64 + l] - as) * ds : 0.f;
          Gs[l * 72 + s] = f2bf(gv);
        }
      }
#pragma unroll
      for (int i = 0; i < 2; ++i) {
        const int id = tid + 256 * i, pr = id >> 3, kc = (id & 7) * 8;
        *(uint4*)(Xs + pr * 72 + kc) = *(const uint4*)(xT + ((size_t)ci * 2048 + h * 64 + pr) * 64 + kc);
      }
#pragma unroll
      for (int i = 0; i < 4; ++i) {
        const int id = tid + 256 * i, pr = id >> 4, kc = (id & 15) * 8;
        *(uint4*)(Bs + pr * 136 + kc) = *(const uint4*)(CS + ((size_t)(ci * 32 + h) * 64 + pr) * 128 + kc);
      }
      __syncthreads();
      f32x16 a1 = zero16(), a2 = zero16();
      a1 = mma_lds(Gs + (wl * 32) * 72, 72, Xs + (w2 * 32) * 72, 72, 64, a1, lane);
      a2 = mma_lds(Cs + (wl * 32) * 136, 136, Bs + (w2 * 32) * 136, 136, 128, a2, lane);
      const float dsk = i_ssd_d[jl * 32 + h];
      const int pp = w2 * 32 + (lane & 31);
#pragma unroll
      for (int r = 0; r < 16; ++r) {
        const int l = wl * 32 + accrow(r, lane);
        if (l < nv) {
          const float xv = bf2f(xc[(size_t)(r0 + l) * 4096 + h * 64 + pp]);
          const float yv = a1[r] + __expf(acsS[hh * 64 + l]) * a2[r] + dsk * xv;
          ys[(size_t)(r0 + l) * 2048 + h * 64 + pp] = f2bf(yv);
        }
      }
      __syncthreads();
    }
  }
}

DEVI void phase_ssd_d(const Params& p, int jl) {
  const float* i_ssd_norm_w = PIN(16);
  char* ar = PW(char, W_arena);
  const bf16* ys = (const bf16*)(ar + S_YS);
  const bf16* zb = (const bf16*)(ar + S_ZB);
  bf16* Yb = (bf16*)(ar + S_YB);
  const float* nw = i_ssd_norm_w + (size_t)jl * 2048;
  const int lane = TID() & 63;
  const int gw = BID() * 4 + (TID() >> 6), nwv = gridDim.x * 4;
  float nwr[32];
#pragma unroll
  for (int i = 0; i < 4; ++i)
#pragma unroll
    for (int e = 0; e < 8; ++e) nwr[i * 8 + e] = nw[(i * 64 + lane) * 8 + e];
  for (int m = gw; m < M; m += nwv) {
    float u[32];
    float ss = 0.f;
#pragma unroll
    for (int i = 0; i < 4; ++i) {
      const int c = (i * 64 + lane) * 8;
      const uint4 yv = *(const uint4*)(ys + (size_t)m * 2048 + c);
      const uint4 zv = *(const uint4*)(zb + (size_t)m * 2048 + c);
      const unsigned ya[4] = {yv.x, yv.y, yv.z, yv.w}, za[4] = {zv.x, zv.y, zv.z, zv.w};
#pragma unroll
      for (int e = 0; e < 4; ++e) {
        const float u0 = bflo(ya[e]) * siluf(bflo(za[e])), u1 = bfhi(ya[e]) * siluf(bfhi(za[e]));
        u[i * 8 + 2 * e] = u0; u[i * 8 + 2 * e + 1] = u1;
        ss += u0 * u0 + u1 * u1;
      }
    }
    const float rs = rsqrtf(wave_sum(ss) * (1.f / 2048.f) + 1e-5f);
#pragma unroll
    for (int i = 0; i < 4; ++i) {
      const int c = (i * 64 + lane) * 8;
      uint4 o;
      o.x = pack2(u[i * 8 + 0] * rs * nwr[i * 8 + 0], u[i * 8 + 1] * rs * nwr[i * 8 + 1]);
      o.y = pack2(u[i * 8 + 2] * rs * nwr[i * 8 + 2], u[i * 8 + 3] * rs * nwr[i * 8 + 3]);
      o.z = pack2(u[i * 8 + 4] * rs * nwr[i * 8 + 4], u[i * 8 + 5] * rs * nwr[i * 8 + 5]);
      o.w = pack2(u[i * 8 + 6] * rs * nwr[i * 8 + 6], u[i * 8 + 7] * rs * nwr[i * 8 + 7]);
      *(uint4*)(Yb + (size_t)m * 2048 + c) = o;
    }
  }
}

DEVI void da_convert_cache(const Params& p, char* smem) {
  const float* i_cache_k = PIN(2);
  const float* i_cache_v = PIN(3);
  char* ar = PW(char, W_arena);
  bf16* Kall = (bf16*)(ar + A_KALL);
  bf16* VTp = (bf16*)(ar + A_VTP);
  bf16* VTs = (bf16*)(ar + A_VTS);
  const int tid = TID();
  const size_t gtid = (size_t)BID() * 256 + tid, nth = (size_t)gridDim.x * 256;
  for (size_t i0 = gtid; i0 < (size_t)NB * 4096 * 128; i0 += nth * 4) {
    float4 v0[4], v1[4];
#pragma unroll
    for (int u = 0; u < 4; ++u) {
      const size_t idx = i0 + u * nth;
      if (idx < (size_t)NB * 4096 * 128) {
        const float* src = i_cache_k + (idx >> 7) * 1024 + (int)(idx & 127) * 8;
        v0[u] = *(const float4*)src; v1[u] = *(const float4*)(src + 4);
      }
    }
#pragma unroll
    for (int u = 0; u < 4; ++u) {
      const size_t idx = i0 + u * nth;
      if (idx < (size_t)NB * 4096 * 128) {
        const size_t rowi = idx >> 7;
        const int c = (int)(idx & 127) * 8;
        const int b = (int)(rowi >> 12), pos = (int)(rowi & 4095);
        uint4 o;
        o.x = pack2(v0[u].x, v0[u].y); o.y = pack2(v0[u].z, v0[u].w); o.z = pack2(v1[u].x, v1[u].y); o.w = pack2(v1[u].z, v1[u].w);
        *(uint4*)(Kall + ((size_t)LDVP + (size_t)b * LDVS + 48 + pos) * 1024 + c) = o;
      }
    }
  }
  for (size_t idx = gtid; idx < (size_t)17 * 48 * 128; idx += nth) {
    const int seq = (int)(idx / (48 * 128)), rem = (int)(idx % (48 * 128));
    const size_t rb = (seq == 0) ? 0 : (size_t)LDVP + (size_t)(seq - 1) * LDVS;
    *(uint4*)(Kall + (rb + (rem >> 7)) * 1024 + (rem & 127) * 8) = make_uint4(0, 0, 0, 0);
  }
  for (size_t idx = gtid; idx < (size_t)(1024 + NB * 1024) * 6; idx += nth) {
    const size_t rowi = idx / 6;
    const int c = (int)(idx % 6) * 8;
    bf16* dst = (rowi < 1024) ? VTp + rowi * LDVP + c : VTs + (rowi - 1024) * LDVS + c;
    *(uint4*)dst = make_uint4(0, 0, 0, 0);
  }
  float* tile = (float*)smem;
  for (int tl = BID(); tl < NB * 8 * 64; tl += gridDim.x) {
    const int b = tl >> 9, h = (tl >> 6) & 7, pt = tl & 63;
    for (int e = tid; e < 64 * 32; e += 256) {
      const int pos = e >> 5, c4 = (e & 31) * 4;
      const float4 v = *(const float4*)(i_cache_v + (((size_t)b * 4096 + pt * 64 + pos) * 8 + h) * 128 + c4);
      tile[pos * 129 + c4] = v.x; tile[pos * 129 + c4 + 1] = v.y; tile[pos * 129 + c4 + 2] = v.z; tile[pos * 129 + c4 + 3] = v.w;
    }
    __syncthreads();
    for (int e = tid; e < 1024; e += 256) {
      const int ee = e & 127, pg = (e >> 7) * 8;
      uint4 o;
      o.x = pack2(tile[(pg + 0) * 129 + ee], tile[(pg + 1) * 129 + ee]);
      o.y = pack2(tile[(pg + 2) * 129 + ee], tile[(pg + 3) * 129 + ee]);
      o.z = pack2(tile[(pg + 4) * 129 + ee], tile[(pg + 5) * 129 + ee]);
      o.w = pack2(tile[(pg + 6) * 129 + ee], tile[(pg + 7) * 129 + ee]);
      *(uint4*)(VTs + ((size_t)(b * 8 + h) * 128 + ee) * LDVS + 48 + pt * 64 + pg) = o;
    }
    __syncthreads();
  }
}

DEVI void attn_item(const Params& p, int seq, int qt, int h, float lam, char* smem) {
  const float* i_da_subln_g = PIN(20);
  char* ar = PW(char, W_arena);
  const bf16* Qb = (const bf16*)(ar + A_QB);
  const bf16* Kbase = (const bf16*)(ar + A_KALL) + ((seq == 0) ? (size_t)0 : ((size_t)LDVP + (size_t)(seq - 1) * LDVS)) * 1024;
  const int ldv = (seq == 0) ? LDVP : LDVS;
  const bf16* VTbase = (seq == 0) ? (const bf16*)(ar + A_VTP) + (size_t)h * 128 * LDVP
                                  : (const bf16*)(ar + A_VTS) + (size_t)((seq - 1) * 8 + h) * 128 * LDVS;
  bf16* Ks = (bf16*)smem;
  bf16* Vs = Ks + 2 * 64 * 72;
  const int tid = TID(), lane = tid & 63, wave = tid >> 6;
  const int c = wave >> 1, rh = wave & 1, hl = lane >> 5;
  const int u = 64 * qt + 32 * rh + (lane & 31);
  int m;
  bool qvalid;
  if (seq == 0) { m = u - 48; qvalid = (m >= 0) && (m < TP); }
  else { const int t = u - 4144; m = TP + 16 * (seq - 1) + t; qvalid = t >= 0; }
  bf16x8 qf[4];
  {
    const bf16x8 zv = {0, 0, 0, 0, 0, 0, 0, 0};
    const bf16* qp = Qb + (size_t)(qvalid ? m : 0) * 1024 + h * 128 + c * 64 + hl * 8;
#pragma unroll
    for (int ks = 0; ks < 4; ++ks) {
      const bf16x8 ld = *(const bf16x8*)(qp + ks * 16);
      qf[ks] = qvalid ? ld : zv;
    }
  }
  f32x16 O[4];
#pragma unroll
  for (int et = 0; et < 4; ++et) O[et] = zero16();
  float mrun = -1e30f, lrun = 0.f;
  const float sc = 0.125f * 1.4426950408889634f;
  const int ntiles = qt + 1;
  u32x4 rk[4], rv[4];
  const int k_row = (tid >> 3) & 63;
#define ATT_LOAD(j)                                                                                          \
  {                                                                                                          \
    _Pragma("unroll") for (int i = 0; i < 4; ++i) {                                                          \
      const int id = tid + 256 * i;                                                                          \
      const int cc = id >> 9, row = (id >> 3) & 63, kc = (id & 7) * 8;                                       \
      rk[i] = *(const u32x4*)(Kbase + (size_t)(64 * (j) + row) * 1024 + h * 128 + cc * 64 + kc);             \
      const int e = id >> 3;                                                                                 \
      rv[i] = *(const u32x4*)(VTbase + (size_t)e * ldv + 64 * (j) + kc);                                     \
    }                                                                                                        \
  }
  (void)k_row;
  constexpr int ABUF = 2 * 64 * 72 + 128 * 68;
#define ATT_STORE(buf)                                                                                       \
  {                                                                                                          \
    bf16* Kd = Ks + (buf) * ABUF;                                                                            \
    bf16* Vd = Kd + 2 * 64 * 72;                                                                             \
    _Pragma("unroll") for (int i = 0; i < 4; ++i) {                                                          \
      const int id = tid + 256 * i;                                                                          \
      const int cc = id >> 9, row = (id >> 3) & 63, kc = (id & 7) * 8;                                       \
      *(u32x4*)(Kd + (cc * 64 + row) * 72 + kc) = rk[i];                                                     \
      const int e = id >> 3;                                                                                 \
      *(uint2*)(Vd + e * 68 + kc) = make_uint2(rv[i].x, rv[i].y);                                            \
      *(uint2*)(Vd + e * 68 + kc + 4) = make_uint2(rv[i].z, rv[i].w);                                        \
    }                                                                                                        \
  }
  ATT_LOAD(0);
  __syncthreads();
  ATT_STORE(0);
  if (ntiles > 1) ATT_LOAD(1);
  __syncthreads();
  for (int j = 0; j < ntiles; ++j) {
    const int cur = j & 1;
    if (j + 1 < ntiles) ATT_STORE(cur ^ 1);
    if (j + 2 < ntiles) ATT_LOAD(j + 2);
    const bf16* Kc = Ks + cur * ABUF;
    const bf16* Vc = Kc + 2 * 64 * 72;
    f32x16 S[2];
#pragma unroll
    for (int kt2 = 0; kt2 < 2; ++kt2) {
      S[kt2] = zero16();
#pragma unroll
      for (int ks = 0; ks < 4; ++ks) {
        const bf16x8 a = *(const bf16x8*)(Kc + (c * 64 + kt2 * 32 + (lane & 31)) * 72 + ks * 16 + hl * 8);
        S[kt2] = mfma32(a, qf[ks], S[kt2]);
      }
      __builtin_amdgcn_sched_barrier(0);
    }
    if (j == 0) {
#pragma unroll
      for (int kt2 = 0; kt2 < 2; ++kt2)
#pragma unroll
        for (int r = 0; r < 16; ++r)
          if (kt2 * 32 + accrow(r, lane) < 48) S[kt2][r] = -1e30f;
    }
    float mx = -1e30f;
#pragma unroll
    for (int kt2 = 0; kt2 < 2; ++kt2)
#pragma unroll
      for (int r = 0; r < 16; ++r) mx = fmaxf(mx, S[kt2][r]);
    mx = fmaxf(mx, __shfl_xor(mx, 32));
    const float mnew = fmaxf(mrun, mx);
    const float msc = mnew * sc;
    float ps = 0.f;
#pragma unroll
    for (int kt2 = 0; kt2 < 2; ++kt2)
#pragma unroll
      for (int r = 0; r < 16; ++r) {
        const float pv = __builtin_amdgcn_exp2f(S[kt2][r] * sc - msc);
        S[kt2][r] = pv;
        ps += pv;
      }
    if (__any(mnew > mrun)) {
      const float alpha = __builtin_amdgcn_exp2f((mrun - mnew) * sc);
      lrun *= alpha;
#pragma unroll
      for (int et = 0; et < 4; ++et)
#pragma unroll
        for (int r = 0; r < 16; ++r) O[et][r] *= alpha;
    }
    mrun = mnew;
    lrun += ps;
    bf16x8 pf[4];
#pragma unroll
    for (int s = 0; s < 4; ++s) {
      union { u32x4 q; bf16x8 v; } cvp;
#pragma unroll
      for (int e = 0; e < 4; ++e) cvp.q[e] = pack2(S[s >> 1][(s & 1) * 8 + 2 * e], S[s >> 1][(s & 1) * 8 + 2 * e + 1]);
      pf[s] = cvp.v;
    }
#pragma unroll
    for (int et = 0; et < 4; ++et) {
#pragma unroll
      for (int s = 0; s < 4; ++s) {
        const bf16* vp = Vc + (et * 32 + (lane & 31)) * 68 + 16 * s + 4 * hl;
        const uint2 v0 = *(const uint2*)vp, v1 = *(const uint2*)(vp + 8);
        union { uint4 q; bf16x8 v; } cv;
        cv.q = make_uint4(v0.x, v0.y, v1.x, v1.y);
        O[et] = mfma32(cv.v, pf[s], O[et]);
      }
      __builtin_amdgcn_sched_barrier(0);
    }
    __syncthreads();
  }
#undef ATT_LOAD
#undef ATT_STORE
  const float ltot = lrun + __shfl_xor(lrun, 32);
  const float inv = 1.f / ltot;
  __syncthreads();
  float* Ox = (float*)smem;
  if (c == 1) {
#pragma unroll
    for (int et = 0; et < 4; ++et)
#pragma unroll
      for (int r = 0; r < 16; ++r) Ox[(rh * 128 + et * 32 + accrow(r, lane)) * 32 + (lane & 31)] = O[et][r] * inv;
  }
  __syncthreads();
  if (c == 0) {
    float ss = 0.f;
#pragma unroll
    for (int et = 0; et < 4; ++et)
#pragma unroll
      for (int r = 0; r < 16; ++r) {
        const float o = O[et][r] * inv - lam * Ox[(rh * 128 + et * 32 + accrow(r, lane)) * 32 + (lane & 31)];
        O[et][r] = o;
        ss += o * o;
      }
    ss += __shfl_xor(ss, 32);
    const float scl = rsqrtf(ss * (1.f / 128.f) + 1e-5f) * (1.f - LAM_INIT);
    if (qvalid) {
      bf16* Ob = (bf16*)(ar + A_OB) + (size_t)m * 1024 + h * 128;
#pragma unroll
      for (int et = 0; et < 4; ++et)
#pragma unroll
        for (int rq = 0; rq < 4; ++rq) {
          const int e0 = et * 32 + 8 * rq + 4 * hl;
          const float4 gg = *(const float4*)(i_da_subln_g + e0);
          uint2 o;
          o.x = pack2(O[et][rq * 4 + 0] * scl * gg.x, O[et][rq * 4 + 1] * scl * gg.y);
          o.y = pack2(O[et][rq * 4 + 2] * scl * gg.z, O[et][rq * 4 + 3] * scl * gg.w);
          *(uint2*)(Ob + e0) = o;
        }
    }
  }
  __syncthreads();
}

DEVI void phase_attn(const Params& p, char* smem, int cidx = 0) {
  const float* i_da_lambda = PIN(19);
  __shared__ int s_item;
  float l1 = 0.f, l2 = 0.f;
  for (int i = 0; i < 64; ++i) {
    l1 += i_da_lambda[i] * i_da_lambda[64 + i];
    l2 += i_da_lambda[128 + i] * i_da_lambda[192 + i];
  }
  const float lam = __expf(l1) - __expf(l2) + LAM_INIT;
  while (true) {
    if (TID() == 0) s_item = atomicAdd(PW(int, W_counters) + cidx, 1);
    __syncthreads();
    const int it = s_item;
    __syncthreads();
    if (it >= 2184) break;
    int seq, qt, h;
    if (it < 1536) { seq = 0; qt = 256 - (it >> 3); h = it & 7; }
    else if (it < 1664) { const int j = it - 1536; seq = 1 + (j >> 3); qt = 64; h = j & 7; }
    else { const int j = it - 1664; seq = 0; qt = 64 - (j >> 3); h = j & 7; }
    attn_item(p, seq, qt, h, lam, smem);
  }
}

DEVI void phase_rk_mix(const Params& p) {
  const float* i_state_shift = PIN(7);
  const float* i_rk_mu = PIN(22);
  const size_t gtid = (size_t)BID() * 256 + TID(), nth = (size_t)gridDim.x * 256;
  bf16* mix = (bf16*)(PW(char, W_arena) + R_MIX);
  const int c = (int)(gtid & 255) * 4;
  float4 mur[6];
#pragma unroll
  for (int k = 0; k < 6; ++k) mur[k] = *(const float4*)(i_rk_mu + (size_t)k * 1024 + c);
  for (size_t idx = gtid; idx < (size_t)M * 256; idx += nth) {
    const int m = (int)(idx >> 8);
    int b = -1, t = m, L = TP;
    if (m >= TP) { b = (m - TP) >> 4; t = (m - TP) & 15; L = 16; }
    const uint2 xb = *(const uint2*)(PW(bf16, W_Xb) + (size_t)m * 1024 + c);
    const float4 x = make_float4(bflo(xb.x), bfhi(xb.x), bflo(xb.y), bfhi(xb.y));
    float4 xp = make_float4(0, 0, 0, 0);
    if (t > 0) {
      const uint2 pb = *(const uint2*)(PW(bf16, W_Xb) + (size_t)(m - 1) * 1024 + c);
      xp = make_float4(bflo(pb.x), bfhi(pb.x), bflo(pb.y), bfhi(pb.y));
    } else if (b >= 0) xp = *(const float4*)(i_state_shift + (size_t)b * 1024 + c);
    const float4 xx = make_float4(xp.x - x.x, xp.y - x.y, xp.z - x.z, xp.w - x.w);
#pragma unroll
    for (int k = 0; k < 6; ++k) {
      const float4 mu = mur[k];
      uint2 o;
      o.x = pack2(x.x + xx.x * mu.x, x.y + xx.y * mu.y);
      o.y = pack2(x.z + xx.z * mu.z, x.w + xx.w * mu.w);
      *(uint2*)(mix + (size_t)k * MP * 1024 + (size_t)m * 1024 + c) = o;
    }
    if (t == L - 1) {
      float* so = (b < 0) ? POUT + O_SHP + c : POUT + O_SHS + (size_t)b * 1024 + c;
      *(float4*)so = x;
    }
  }
}

DEVI void phase_rk_g1(const Params& p, char* smem) {
  char* ar = PW(char, W_arena);
  const bf16* mix = (const bf16*)(ar + R_MIX);
  const int NTT = 28, total = MT * NTT;
  for (int id = BID(); id < total; id += gridDim.x) {
    int mt, ntg;
    tile_decode(id, NTT, mt, ntg);
    GJob jb;
    jb.lda = 1024; jb.K = 1024; jb.aux = 0; jb.of = nullptr;
    int nt;
    if (ntg < 8) { jb.A = mix + (size_t)0 * MP * 1024; jb.Bt = PW(bf16, W_wt_r); jb.epi = EPI_BF16; jb.of = (float*)(ar + R_R); nt = ntg; }
    else if (ntg < 16) { jb.A = mix + (size_t)2 * MP * 1024; jb.Bt = PW(bf16, W_wt_k); jb.epi = EPI_BF16; jb.of = (float*)(ar + R_K); nt = ntg - 8; }
    else if (ntg < 24) { jb.A = mix + (size_t)3 * MP * 1024; jb.Bt = PW(bf16, W_wt_v); jb.epi = EPI_BF16; jb.of = (float*)(ar + R_V); nt = ntg - 16; }
    else if (ntg == 24) { jb.A = mix + (size_t)1 * MP * 1024; jb.Bt = PW(bf16, W_wt_w1); jb.epi = EPI_RK_W1; nt = 0; }
    else if (ntg == 25) { jb.A = mix + (size_t)4 * MP * 1024; jb.Bt = PW(bf16, W_wt_a1); jb.epi = EPI_RK_A1; nt = 0; }
    else { jb.A = mix + (size_t)5 * MP * 1024; jb.Bt = PW(bf16, W_wt_g1); jb.epi = EPI_RK_G1; nt = ntg - 26; }
    gemm_tile(p, jb, mt * 128, nt * 128, smem);
  }
}

DEVI void phase_rk_g2(const Params& p, char* smem) {
  char* ar = PW(char, W_arena);
  const int NTT = 24, total = MT * NTT;
  for (int id = BID(); id < total; id += gridDim.x) {
    int mt, ntg;
    tile_decode(id, NTT, mt, ntg);
    GJob jb;
    jb.aux = 0; jb.of = nullptr;
    int nt;
    if (ntg < 8) { jb.A = (const bf16*)(ar + R_HW); jb.lda = 64; jb.K = 64; jb.Bt = PW(bf16, W_wt_w2); jb.epi = EPI_RK_W2; nt = ntg; }
    else if (ntg < 16) { jb.A = (const bf16*)(ar + R_HA); jb.lda = 64; jb.K = 64; jb.Bt = PW(bf16, W_wt_a2); jb.epi = EPI_RK_A2; nt = ntg - 8; }
    else { jb.A = (const bf16*)(ar + R_HG); jb.lda = 192; jb.K = 192; jb.Bt = PW(bf16, W_wt_g2); jb.epi = EPI_BF16; jb.of = (float*)(ar + R_G); nt = ntg - 16; }
    gemm_tile(p, jb, mt * 128, nt * 128, smem);
  }
}

DEVI void phase_rk_prep(const Params& p) {
  const float* i_rk_k_k = PIN(31);
  const float* i_rk_k_a = PIN(32);
  char* ar = PW(char, W_arena);
  bf16* Kr = (bf16*)(ar + R_K);
  const bf16* A = (const bf16*)(ar + R_A);
  bf16* KK = (bf16*)(ar + R_KK);
  bf16* BV = (bf16*)(ar + R_BV);
  const int lane = TID() & 63;
  const int gw = BID() * 4 + (TID() >> 6), nw = gridDim.x * 4;
  int cc = -1;
  float kkw = 0.f, kaw = 0.f;
  for (int i0 = gw; i0 < M * 16; i0 += nw * 4) {
    float kv[4], av[4];
#pragma unroll
    for (int u = 0; u < 4; ++u) {
      const int it = min(i0 + u * nw, M * 16 - 1);
      const size_t o = (size_t)(it >> 4) * 1024 + (it & 15) * 64 + lane;
      kv[u] = bf2f(Kr[o]); av[u] = bf2f(A[o]);
    }
#pragma unroll
    for (int u = 0; u < 4; ++u) {
      const int it = i0 + u * nw;
      const int c = (min(it, M * 16 - 1) & 15) * 64 + lane;
      if (c != cc) { cc = c; kkw = i_rk_k_k[c]; kaw = i_rk_k_a[c]; }
      const float kk = kv[u] * kkw;
      const float nrm = sqrtf(wave_sum(kk * kk));
      if (it < M * 16) {
        const size_t o = (size_t)(it >> 4) * 1024 + c;
        const float kkn = kk / fmaxf(nrm, 1e-12f);
        Kr[o] = f2bf(kv[u] * (1.f + (av[u] - 1.f) * kaw));
        KK[o] = f2bf(kkn);
        BV[o] = f2bf(kkn * av[u]);
      }
    }
  }
}

DEVI void phase_rk_scan(const Params& p, char* smem) {
  const float* i_state_wkv = PIN(6);
  char* ar = PW(char, W_arena);
  const bf16* src0 = (const bf16*)(ar + R_R);
  const float* src1 = (const float*)(ar + R_W);
  const bf16* src2 = (const bf16*)(ar + R_K);
  const bf16* src3 = (const bf16*)(ar + R_KK);
  const bf16* src4 = (const bf16*)(ar + R_BV);
  const bf16* src5 = (const bf16*)(ar + R_V);
  float* Y = (float*)(ar + R_Y);
  float* outp = POUT;
  float* st = (float*)smem;
  const int tid = TID(), lane = tid & 63, wave = tid >> 6;
  float* yb = st + 6 * 32 * 64 + wave * (16 * 68);
  for (int it = BID(); it < 256 + 4096; it += gridDim.x) {
    int b, h, rg, mbase, L;
    if (it < 256) { b = -1; h = it & 15; rg = it >> 4; mbase = 0; L = TP; }
    else { const int j = it - 256; b = j >> 8; h = (j >> 4) & 15; rg = j & 15; mbase = TP + 16 * b; L = 16; }
    const int row = rg * 4 + wave;
    float S = (b < 0) ? 0.f : i_state_wkv[((size_t)(b * 16 + h) * 64 + row) * 64 + lane];
    const int nst = (L + 31) >> 5;
    f32x4 rgw[2];
    uint2 rgb[10];
    const int lr = (tid >> 4), lc4 = (tid & 15) * 4;
#define RK_LOAD(s)                                                                             \
  {                                                                                            \
    _Pragma("unroll") for (int hf = 0; hf < 2; ++hf) {                                         \
      const int tt = (s) * 32 + lr + 16 * hf;                                                  \
      const size_t go = (size_t)(mbase + tt) * 1024 + h * 64 + lc4;                            \
      const f32x4 zz = {0.f, 0.f, 0.f, 0.f};                                                   \
      const bool ok = tt < L;                                                                  \
      rgw[hf] = ok ? *(const f32x4*)(src1 + go) : zz;                                          \
      rgb[0 + hf] = ok ? *(const uint2*)(src0 + go) : make_uint2(0, 0);                        \
      rgb[2 + hf] = ok ? *(const uint2*)(src2 + go) : make_uint2(0, 0);                        \
      rgb[4 + hf] = ok ? *(const uint2*)(src3 + go) : make_uint2(0, 0);                        \
      rgb[6 + hf] = ok ? *(const uint2*)(src4 + go) : make_uint2(0, 0);                        \
      rgb[8 + hf] = ok ? *(const uint2*)(src5 + go) : make_uint2(0, 0);                        \
    }                                                                                          \
  }
    RK_LOAD(0);
    for (int s = 0; s < nst; ++s) {
      __syncthreads();
#pragma unroll
      for (int hf = 0; hf < 2; ++hf) {
        const int rr = lr + 16 * hf;
        *(f32x4*)(st + (1 * 32 + rr) * 64 + lc4) = rgw[hf];
#pragma unroll
        for (int a5 = 0; a5 < 5; ++a5) {
          const int arr = (a5 == 0) ? 0 : a5 + 1;
          const uint2 q = rgb[2 * a5 + hf];
          *(f32x4*)(st + (arr * 32 + rr) * 64 + lc4) = f32x4{bflo(q.x), bfhi(q.x), bflo(q.y), bfhi(q.y)};
        }
      }
      __syncthreads();
      if (s + 1 < nst) RK_LOAD(s + 1);
      const int nstep = min(32, L - s * 32);
      for (int q0 = 0; q0 < nstep; q0 += 16) {
#pragma unroll
        for (int g8 = 0; g8 < 16; g8 += 8) {
          float r_[8], w_[8], k_[8], kk_[8], bv_[8], v_[8];
#pragma unroll
          for (int u = 0; u < 8; ++u) {
            const int q = q0 + g8 + u;
            r_[u] = st[(0 * 32 + q) * 64 + lane]; w_[u] = st[(1 * 32 + q) * 64 + lane]; k_[u] = st[(2 * 32 + q) * 64 + lane];
            kk_[u] = st[(3 * 32 + q) * 64 + lane]; bv_[u] = st[(4 * 32 + q) * 64 + lane]; v_[u] = st[(5 * 32 + q) * 64 + row];
          }
#pragma unroll
          for (int u = 0; u < 8; ++u) {
            const float base = S * w_[u] + v_[u] * k_[u];
            const float sa = wave_sum63(S * kk_[u]);
            S = base - sa * bv_[u];
            yb[(g8 + u) * 68 + lane] = S * r_[u];
          }
        }
        if (lane < 16) {
          const float* yr = yb + lane * 68;
          f32x4 acc = *(const f32x4*)yr;
#pragma unroll
          for (int j = 1; j < 16; ++j) acc += *(const f32x4*)(yr + 4 * j);
          Y[(size_t)(mbase + s * 32 + q0 + lane) * 1024 + h * 64 + row] = (acc[0] + acc[1]) + (acc[2] + acc[3]);
        }
      }
    }
#undef RK_LOAD
    float* so = (b < 0) ? outp + O_WKVP + ((size_t)h * 64 + row) * 64 + lane
                        : outp + O_WKVS + ((size_t)(b * 16 + h) * 64 + row) * 64 + lane;
    *so = S;
  }
  if (BID() >= 256 && gridDim.x > 256) {
    __syncthreads();
    convert_weights(p, smem, 2, BID() - 256, gridDim.x - 256);
  }
}

DEVI void phase_rk_post(const Params& p) {
  const float* i_rk_lnx_g = PIN(38);
  const float* i_rk_lnx_b = PIN(39);
  const float* i_rk_r_k = PIN(33);
  char* ar = PW(char, W_arena);
  const float* Y = (const float*)(ar + R_Y);
  const bf16* R = (const bf16*)(ar + R_R);
  const bf16* Kr = (const bf16*)(ar + R_K);
  const bf16* V = (const bf16*)(ar + R_V);
  const bf16* G = (const bf16*)(ar + R_G);
  bf16* Yb = (bf16*)(ar + R_YB);
  const int lane = TID() & 63;
  const int gw = BID() * 4 + (TID() >> 6), nw = gridDim.x * 4;
  int cc = -1;
  float lg = 0.f, lb = 0.f, rkw = 0.f;
  for (int i0 = gw; i0 < M * 16; i0 += nw * 4) {
    float y[4], rk[4], vv[4], gg[4];
#pragma unroll
    for (int u = 0; u < 4; ++u) {
      const int it = min(i0 + u * nw, M * 16 - 1);
      const size_t o = (size_t)(it >> 4) * 1024 + (it & 15) * 64 + lane;
      y[u] = Y[o]; rk[u] = bf2f(R[o]) * bf2f(Kr[o]); vv[u] = bf2f(V[o]); gg[u] = bf2f(G[o]);
    }
#pragma unroll
    for (int u = 0; u < 4; ++u) {
      const int it = i0 + u * nw;
      const int c = (min(it, M * 16 - 1) & 15) * 64 + lane;
      if (c != cc) { cc = c; lg = i_rk_lnx_g[c]; lb = i_rk_lnx_b[c]; rkw = i_rk_r_k[c]; }
      const float mean = wave_sum(y[u]) * (1.f / 64.f);
      const float dy = y[u] - mean;
      const float var = wave_sum(dy * dy) * (1.f / 64.f);
      const float yn = dy * rsqrtf(var + 64e-5f) * lg + lb;
      const float bonus = wave_sum(rk[u] * rkw) * vv[u];
      if (it < M * 16) Yb[(size_t)(it >> 4) * 1024 + c] = f2bf((yn + bonus) * gg[u]);
    }
  }
}

enum {
  OP_PREP = 0, OP_SSD_IN, OP_SSD_E1, OP_SSD_A, OP_SSD_B, OP_SSD_C, OP_SSD_D, OP_SSD_OUT, OP_LN, OP_FFN_GU, OP_FFN_E,
  OP_FFN_DOWN, OP_QKV, OP_ATTN, OP_DA_O, OP_RK_MIX, OP_RK_G1, OP_RK_G2, OP_RK_PREP, OP_RK_SCAN, OP_RK_POST, OP_RK_O
};
constexpr int NPH = 43;
__constant__ unsigned char PROG[NPH][2] = {
    {OP_PREP, 0},
    {OP_SSD_IN, 0}, {OP_SSD_E1, 0}, {OP_SSD_A, 0}, {OP_SSD_B, 0}, {OP_SSD_C, 0}, {OP_SSD_D, 0}, {OP_SSD_OUT, 0}, {OP_LN, 0},
    {OP_FFN_GU, 0}, {OP_FFN_DOWN, 0}, {OP_LN, 1},
    {OP_QKV, 0}, {OP_ATTN, 0}, {OP_DA_O, 0}, {OP_LN, 2},
    {OP_FFN_GU, 1}, {OP_FFN_DOWN, 1}, {OP_LN, 3},
    {OP_RK_MIX, 0}, {OP_RK_G1, 0}, {OP_RK_G2, 0}, {OP_RK_PREP, 0}, {OP_RK_SCAN, 0}, {OP_RK_POST, 0}, {OP_RK_O, 0}, {OP_LN, 4},
    {OP_FFN_GU, 2}, {OP_FFN_DOWN, 2}, {OP_LN, 5},
    {OP_SSD_IN, 1}, {OP_SSD_E1, 1}, {OP_SSD_A, 1}, {OP_SSD_B, 1}, {OP_SSD_C, 1}, {OP_SSD_D, 1}, {OP_SSD_OUT, 1}, {OP_LN, 6},
    {OP_FFN_GU, 3}, {OP_FFN_DOWN, 3}, {OP_LN, 7}};

DEVI void run_op(const Params& p, const int op, const int a, char* smem) {
  GJob jb;
  jb.aux = 0; jb.of = nullptr;
  switch (op) {
    case OP_PREP: phase_prep(p, smem); break;
    case OP_SSD_IN:
      jb.A = PW(bf16, W_Xb); jb.lda = 1024; jb.K = 1024; jb.Bt = PW(bf16, W_wt_ssd_in) + (size_t)a * 6272 * 1024; jb.epi = EPI_SSD_IN;
      gemm_single(p, jb, 49, smem);
      break;
    case OP_SSD_E1: phase_ssd_e1(p, a, smem); break;
    case OP_SSD_A: phase_ssd_a(p, a, smem); break;
    case OP_SSD_B: phase_ssd_b(p, a, smem); break;
    case OP_SSD_C: phase_ssd_c(p, a, smem); break;
    case OP_SSD_D: phase_ssd_d(p, a); break;
    case OP_SSD_OUT:
      jb.A = (const bf16*)(PW(char, W_arena) + S_YB); jb.lda = 2048; jb.K = 2048; jb.Bt = PW(bf16, W_wt_ssd_out) + (size_t)a * 1024 * 2048; jb.epi = EPI_RESID;
      gemm_single(p, jb, 8, smem);
      break;
    case OP_LN: phase_ln(p, a, a == 7); break;
    case OP_FFN_GU:
      jb.A = PW(bf16, W_Xb); jb.lda = 1024; jb.K = 1024; jb.Bt = PW(bf16, W_wt_gu) + (size_t)a * 5632 * 1024; jb.epi = EPI_GU; jb.aux = a;
      gemm_single(p, jb, 44, smem);
      break;
    case OP_FFN_E: phase_ffn_e(p, a); break;
    case OP_FFN_DOWN:
      jb.A = (const bf16*)(PW(char, W_arena) + F_HB); jb.lda = 2816; jb.K = 2816; jb.Bt = PW(bf16, W_wt_down) + (size_t)a * 1024 * 2816; jb.epi = EPI_RESID;
      gemm_single(p, jb, 8, smem);
      break;
    case OP_QKV:
      jb.A = PW(bf16, W_Xb); jb.lda = 1024; jb.K = 1024; jb.Bt = PW(bf16, W_wt_qkv); jb.epi = EPI_QKV;
      if (BID() & 1) { da_convert_cache(p, smem); gemm_single(p, jb, 24, smem); }
      else { gemm_single(p, jb, 24, smem); da_convert_cache(p, smem); }
      break;
    case OP_ATTN: phase_attn(p, smem); break;
    case OP_DA_O:
      jb.A = (const bf16*)(PW(char, W_arena) + A_OB); jb.lda = 1024; jb.K = 1024; jb.Bt = PW(bf16, W_wt_o); jb.epi = EPI_RESID;
      gemm_single(p, jb, 8, smem);
      break;
    case OP_RK_MIX: phase_rk_mix(p); break;
    case OP_RK_G1: phase_rk_g1(p, smem); break;
    case OP_RK_G2: phase_rk_g2(p, smem); break;
    case OP_RK_PREP: phase_rk_prep(p); break;
    case OP_RK_SCAN: phase_rk_scan(p, smem); break;
    case OP_RK_POST: phase_rk_post(p); break;
    case OP_RK_O:
      jb.A = (const bf16*)(PW(char, W_arena) + R_YB); jb.lda = 1024; jb.K = 1024; jb.Bt = PW(bf16, W_wt_ro); jb.epi = EPI_RESID;
      gemm_single(p, jb, 8, smem);
      break;
    default: break;
  }
}

#if MK_COOP
__global__ void __launch_bounds__(256, 2) mega(Params p, int ph_lo, int ph_hi) {
  __shared__ __attribute__((aligned(16))) char smem[SMEM_BYTES];
  unsigned* gw = (unsigned*)(p.ws + W_counters);
  const unsigned xcc = xcc_id();
  if (threadIdx.x == 0) add_agent(&gw[GB_XCNT + 64 * xcc], 1u);
  unsigned ncnt = 0, nx = 0, gen = 0;
  for (int ph = ph_lo; ph < ph_hi; ++ph) {
    run_op(p, PROG[ph][0], PROG[ph][1], smem);
#ifdef PROBE_REP
    {
      const int op = PROG[ph][0];
      const bool isg = (op == OP_SSD_IN || op == OP_SSD_OUT || op == OP_FFN_GU || op == OP_FFN_DOWN || op == OP_DA_O || op == OP_RK_G1 || op == OP_RK_G2 || op == OP_RK_O);
      if ((PROBE_REP & 1) && isg) run_op(p, op, PROG[ph][1], smem);
      if ((PROBE_REP & 256) && op == OP_FFN_GU) run_op(p, op, PROG[ph][1], smem);
      if ((PROBE_REP & 512) && op == OP_FFN_DOWN) run_op(p, op, PROG[ph][1], smem);
      if ((PROBE_REP & 1024) && op == OP_SSD_IN) run_op(p, op, PROG[ph][1], smem);
      if ((PROBE_REP & 2) && op == OP_ATTN) phase_attn(p, smem, 1);
      if ((PROBE_REP & 4) && op == OP_RK_SCAN) run_op(p, op, PROG[ph][1], smem);
      if ((PROBE_REP & 8) && (op == OP_LN || op == OP_FFN_E || op == OP_SSD_E1 || op == OP_SSD_D || op == OP_RK_MIX || op == OP_RK_POST)) run_op(p, op, PROG[ph][1], smem);
      if ((PROBE_REP & 32) && op == OP_PREP) run_op(p, op, PROG[ph][1], smem);
      if ((PROBE_REP & 64) && op == OP_QKV) run_op(p, op, PROG[ph][1], smem);
      if ((PROBE_REP & 16) && (op == OP_SSD_A || op == OP_SSD_C)) run_op(p, op, PROG[ph][1], smem);
    }
#endif
    if (ph + 1 < ph_hi) {
      if (ph == ph_lo) {
        if (ph_hi < 0) cg::this_grid().sync();
        asm volatile("s_waitcnt vmcnt(0) lgkmcnt(0)" ::: "memory");
        __syncthreads();
        if (threadIdx.x == 0) {
          __builtin_amdgcn_fence(__ATOMIC_RELEASE, "agent");
          asm volatile("s_waitcnt vmcnt(0)" ::: "memory");
          add_agent(&gw[64], 1u);
          gb_spin(&gw[64], gridDim.x);
          __builtin_amdgcn_fence(__ATOMIC_ACQUIRE, "agent");
          asm volatile("s_waitcnt vmcnt(0)" ::: "memory");
          ncnt = ld_agent(&gw[GB_XCNT + 64 * xcc]);
          for (int j = 0; j < 16; ++j) nx += (ld_agent(&gw[GB_XCNT + 64 * j]) != 0u) ? 1u : 0u;
        }
        __syncthreads();
      } else {
        ++gen;
        gbar(gw, xcc, ncnt, nx, gen);
#ifdef PROBE_REP
        if (PROBE_REP & 128) { ++gen; gbar(gw, xcc, ncnt, nx, gen); ++gen; gbar(gw, xcc, ncnt, nx, gen); }
#endif
      }
    }
  }
}
#endif

#if !MK_COOP
template <int OP>
__global__ void __launch_bounds__(256, 2) phase_kernel(Params p, int a) {
  __shared__ __attribute__((aligned(16))) char smem[SMEM_BYTES];
  run_op(p, OP, a, smem);
}

static const unsigned char PROG_H[NPH][2] = {
    {OP_PREP, 0},
    {OP_SSD_IN, 0}, {OP_SSD_E1, 0}, {OP_SSD_A, 0}, {OP_SSD_B, 0}, {OP_SSD_C, 0}, {OP_SSD_D, 0}, {OP_SSD_OUT, 0}, {OP_LN, 0},
    {OP_FFN_GU, 0}, {OP_FFN_DOWN, 0}, {OP_LN, 1},
    {OP_QKV, 0}, {OP_ATTN, 0}, {OP_DA_O, 0}, {OP_LN, 2},
    {OP_FFN_GU, 1}, {OP_FFN_DOWN, 1}, {OP_LN, 3},
    {OP_RK_MIX, 0}, {OP_RK_G1, 0}, {OP_RK_G2, 0}, {OP_RK_PREP, 0}, {OP_RK_SCAN, 0}, {OP_RK_POST, 0}, {OP_RK_O, 0}, {OP_LN, 4},
    {OP_FFN_GU, 2}, {OP_FFN_DOWN, 2}, {OP_LN, 5},
    {OP_SSD_IN, 1}, {OP_SSD_E1, 1}, {OP_SSD_A, 1}, {OP_SSD_B, 1}, {OP_SSD_C, 1}, {OP_SSD_D, 1}, {OP_SSD_OUT, 1}, {OP_LN, 6},
    {OP_FFN_GU, 3}, {OP_FFN_DOWN, 3}, {OP_LN, 7}};

template <int OP>
static void launch_op(const Params& p, int a, hipStream_t stream) {
  phase_kernel<OP><<<dim3(512), dim3(256), 0, stream>>>(p, a);
}
static void launch_phase(const Params& p, int op, int a, hipStream_t s) {
  switch (op) {
    case OP_PREP: launch_op<OP_PREP>(p, a, s); break;
    case OP_SSD_IN: launch_op<OP_SSD_IN>(p, a, s); break;
    case OP_SSD_E1: launch_op<OP_SSD_E1>(p, a, s); break;
    case OP_SSD_A: launch_op<OP_SSD_A>(p, a, s); break;
    case OP_SSD_B: launch_op<OP_SSD_B>(p, a, s); break;
    case OP_SSD_C: launch_op<OP_SSD_C>(p, a, s); break;
    case OP_SSD_D: launch_op<OP_SSD_D>(p, a, s); break;
    case OP_SSD_OUT: launch_op<OP_SSD_OUT>(p, a, s); break;
    case OP_LN: launch_op<OP_LN>(p, a, s); break;
    case OP_FFN_GU: launch_op<OP_FFN_GU>(p, a, s); break;
    case OP_FFN_E: launch_op<OP_FFN_E>(p, a, s); break;
    case OP_FFN_DOWN: launch_op<OP_FFN_DOWN>(p, a, s); break;
    case OP_QKV: launch_op<OP_QKV>(p, a, s); break;
    case OP_ATTN: launch_op<OP_ATTN>(p, a, s); break;
    case OP_DA_O: launch_op<OP_DA_O>(p, a, s); break;
    case OP_RK_MIX: launch_op<OP_RK_MIX>(p, a, s); break;
    case OP_RK_G1: launch_op<OP_RK_G1>(p, a, s); break;
    case OP_RK_G2: launch_op<OP_RK_G2>(p, a, s); break;
    case OP_RK_PREP: launch_op<OP_RK_PREP>(p, a, s); break;
    case OP_RK_SCAN: launch_op<OP_RK_SCAN>(p, a, s); break;
    case OP_RK_POST: launch_op<OP_RK_POST>(p, a, s); break;
    default: launch_op<OP_RK_O>(p, a, s); break;
  }
}

#endif

extern "C" void kernel_launch(void* const* d_in, const int* in_sizes, int n_in, void* d_out, int out_size, void* d_ws,
                              size_t ws_size, hipStream_t stream) {
  Params p{};
  for (int i = 0; i < 47; ++i) p.in[i] = (const float*)d_in[i];
  p.out = (float*)d_out;
  p.ws = (char*)d_ws;
  if (W_TOTAL > ws_size || n_in < 47) {
    fprintf(stderr, "workspace too small: need %zu have %zu\n", (size_t)W_TOTAL, ws_size);
    return;
  }
#if MK_COOP
  static int grid_blocks = 0;
  if (!grid_blocks) {
    int dev = 0, cus = 0, per_cu = 0;
    hipGetDevice(&dev);
    hipDeviceGetAttribute(&cus, hipDeviceAttributeMultiprocessorCount, dev);
    hipOccupancyMaxActiveBlocksPerMultiprocessor(&per_cu, mega, 256, 0);
    if (per_cu > 2) per_cu = 2;
    grid_blocks = cus * per_cu;
  }
  hipMemsetAsync((char*)d_ws + W_counters, 0, 16384, stream);
  int lo = 0, hi = NPH;
  void* args[] = {&p, &lo, &hi};
  hipError_t e = hipLaunchCooperativeKernel((void*)mega, dim3(grid_blocks), dim3(256), args, 0, stream);
  if (e != hipSuccess) fprintf(stderr, "cooperative launch failed: %s (grid %d)\n", hipGetErrorString(e), grid_blocks);
#else
  for (int ph = 0; ph < NPH; ++ph) launch_phase(p, PROG_H[ph][0], PROG_H[ph][1], stream);
#endif
}
```

```cpp
#include <hip/hip_runtime.h>
#include <hip/hip_cooperative_groups.h>
#include <cstdio>
#include <cstdint>
namespace cg = cooperative_groups;

typedef unsigned short bf16;
typedef __attribute__((ext_vector_type(8))) short bf16x8;
typedef __attribute__((ext_vector_type(16))) float f32x16;
typedef __attribute__((ext_vector_type(4))) unsigned u32x4;
typedef __attribute__((ext_vector_type(4))) float f32x4;

#define DEVI __device__ __forceinline__

#ifndef MK_COOP
#define MK_COOP 1
#endif

constexpr int D = 1024, TP = 16400, NB = 16, M = 16656, MP = 16768, MT = 131;
constexpr int NCH = 273;
constexpr int LDVP = 16448, LDVS = 4160;
constexpr int KROWS = LDVP + NB * LDVS;
constexpr float ALPHA = 1.681792830507429f;
constexpr float LAM_INIT = 0.35550906f;
constexpr int SMEM_BYTES = 73728;

constexpr size_t O_YP = 0;
constexpr size_t O_YS = O_YP + (size_t)16384 * 1024;
constexpr size_t O_KP = O_YS + (size_t)256 * 1024;
constexpr size_t O_VP = O_KP + (size_t)TP * 1024;
constexpr size_t O_SSMP = O_VP + (size_t)TP * 1024;
constexpr size_t O_SCP = O_SSMP + (size_t)2 * 32 * 64 * 128;
constexpr size_t O_WKVP = O_SCP + (size_t)2 * 3 * 4096;
constexpr size_t O_SHP = O_WKVP + (size_t)16 * 64 * 64;
constexpr size_t O_FCP = O_SHP + 1024;
constexpr size_t O_KS = O_FCP + (size_t)4 * 2 * 2816;
constexpr size_t O_VS = O_KS + (size_t)256 * 1024;
constexpr size_t O_SSMS = O_VS + (size_t)256 * 1024;
constexpr size_t O_SCS = O_SSMS + (size_t)2 * 16 * 32 * 64 * 128;
constexpr size_t O_WKVS = O_SCS + (size_t)2 * 16 * 3 * 4096;
constexpr size_t O_SHS = O_WKVS + (size_t)16 * 16 * 64 * 64;
constexpr size_t O_FCS = O_SHS + (size_t)16 * 1024;
constexpr size_t O_TOTAL = O_FCS + (size_t)4 * 16 * 2 * 2816;

struct Params {
  const float* in[47];
  float* out;
  char* ws;
};
DEVI int lnd(int i) { asm volatile("" : "+s"(i)); return i; }
#define GAS __attribute__((address_space(1)))
DEVI const float* gl_in(const float* q) {
  unsigned long long v = (unsigned long long)q;
  asm volatile("" : "+s"(v));
  return (const float*)(const GAS float*)v;
}
#define PIN(i) (gl_in(p.in[lnd(i)]))
DEVI char* lndp(char* x) {
  unsigned long long v = (unsigned long long)x;
  asm volatile("" : "+s"(v));
  return (char*)(GAS char*)v;
}
DEVI float* lndf(float* x) {
  unsigned long long v = (unsigned long long)x;
  asm volatile("" : "+s"(v));
  return (float*)(GAS float*)v;
}
#define PW(T, off) ((T*)(lndp(p.ws) + (off)))
#define POUT (lndf(p.out))


constexpr size_t AL(size_t x) { return (x + 255) & ~(size_t)255; }
constexpr size_t S_ZB = 0;
constexpr size_t S_XBC = S_ZB + AL((size_t)MP * 2048 * 2);
constexpr size_t S_XC = S_XBC + AL((size_t)MP * 4096 * 2);
constexpr size_t S_XT = S_XC + AL((size_t)MP * 4096 * 2);
constexpr size_t S_BT = S_XT + AL((size_t)NCH * 2048 * 64 * 2);
constexpr size_t S_DTRAW = S_BT + AL((size_t)NCH * 1024 * 64 * 2);
constexpr size_t S_DT = S_DTRAW + AL((size_t)MP * 32 * 4);
constexpr size_t S_CS = S_DT + AL((size_t)MP * 32 * 4);
constexpr size_t S_CD = S_CS + AL((size_t)NCH * 32 * 64 * 128 * 2);
constexpr size_t S_END = S_CD + AL((size_t)NCH * 32 * 4);
constexpr size_t S_YS = S_XBC;
constexpr size_t S_YB = S_XBC + AL((size_t)MP * 2048 * 2);
constexpr size_t F_GU = 0;
constexpr size_t F_HB = F_GU + AL((size_t)MP * 5632 * 2);
constexpr size_t F_END = F_HB + AL((size_t)MP * 2816 * 2);
constexpr size_t A_QB = 0;
constexpr size_t A_KALL = A_QB + AL((size_t)MP * 1024 * 2);
constexpr size_t A_VTP = A_KALL + AL((size_t)KROWS * 1024 * 2);
constexpr size_t A_VTS = A_VTP + AL((size_t)1024 * LDVP * 2);
constexpr size_t A_OB = A_VTS + AL((size_t)NB * 1024 * LDVS * 2);
constexpr size_t A_END = A_OB + AL((size_t)MP * 1024 * 2);
constexpr size_t R_MIX = 0;
constexpr size_t R_R = R_MIX + AL((size_t)6 * MP * 1024 * 2);
constexpr size_t R_K = R_R + AL((size_t)MP * 1024 * 4);
constexpr size_t R_V = R_K + AL((size_t)MP * 1024 * 4);
constexpr size_t R_HW = R_V + AL((size_t)MP * 1024 * 4);
constexpr size_t R_HA = R_HW + AL((size_t)MP * 64 * 2);
constexpr size_t R_HG = R_HA + AL((size_t)MP * 64 * 2);
constexpr size_t R_KK = R_HG + AL((size_t)MP * 192 * 2);
constexpr size_t R_BV = R_KK + AL((size_t)MP * 1024 * 4);
constexpr size_t R_Y = R_BV + AL((size_t)MP * 1024 * 4);
constexpr size_t R_YB = R_Y + AL((size_t)MP * 1024 * 4);
constexpr size_t R_END = R_YB + AL((size_t)MP * 1024 * 2);
constexpr size_t R_W = R_MIX;
constexpr size_t R_A = R_MIX + (size_t)MP * 1024 * 4;
constexpr size_t R_G = R_MIX + (size_t)2 * MP * 1024 * 4;
constexpr size_t cmax(size_t a, size_t b) { return a > b ? a : b; }
constexpr size_t ARENA_BYTES = cmax(cmax(S_END, F_END), cmax(A_END, R_END));
constexpr size_t W_counters = 0;
constexpr size_t W_wt_ssd_in = W_counters + AL(16384);
constexpr size_t W_wt_ssd_out = W_wt_ssd_in + AL((size_t)2 * 6272 * 1024 * 2);
constexpr size_t W_wt_qkv = W_wt_ssd_out + AL((size_t)2 * 1024 * 2048 * 2);
constexpr size_t W_wt_o = W_wt_qkv + AL((size_t)3072 * 1024 * 2);
constexpr size_t W_wt_r = W_wt_o + AL((size_t)1024 * 1024 * 2);
constexpr size_t W_wt_k = W_wt_r + AL((size_t)1024 * 1024 * 2);
constexpr size_t W_wt_v = W_wt_k + AL((size_t)1024 * 1024 * 2);
constexpr size_t W_wt_ro = W_wt_v + AL((size_t)1024 * 1024 * 2);
constexpr size_t W_wt_w1 = W_wt_ro + AL((size_t)1024 * 1024 * 2);
constexpr size_t W_wt_a1 = W_wt_w1 + AL((size_t)128 * 1024 * 2);
constexpr size_t W_wt_g1 = W_wt_a1 + AL((size_t)128 * 1024 * 2);
constexpr size_t W_wt_w2 = W_wt_g1 + AL((size_t)256 * 1024 * 2);
constexpr size_t W_wt_a2 = W_wt_w2 + AL((size_t)1024 * 64 * 2);
constexpr size_t W_wt_g2 = W_wt_a2 + AL((size_t)1024 * 64 * 2);
constexpr size_t W_wt_gu = W_wt_g2 + AL((size_t)1024 * 192 * 2);
constexpr size_t W_wt_down = W_wt_gu + AL((size_t)4 * 5632 * 1024 * 2);
constexpr size_t W_X = W_wt_down + AL((size_t)4 * 1024 * 2816 * 2);
constexpr size_t W_Z = W_X + AL((size_t)MP * 1024 * 4);
constexpr size_t W_Xb = W_Z + AL((size_t)MP * 1024 * 4);
constexpr size_t W_cs = W_Xb + AL((size_t)MP * 1024 * 2);
constexpr size_t W_ZT = W_cs + AL((size_t)MP * 64 * 4);
constexpr size_t W_arena = W_ZT + AL((size_t)384 * 1024 * 4);
constexpr size_t W_TOTAL = W_arena + AL(ARENA_BYTES);

DEVI int TID() { int t = threadIdx.x; asm volatile("" : "+v"(t)); return t; }
DEVI int BID() { int b = blockIdx.x; asm volatile("" : "+s"(b)); return b; }
typedef float f32x2 __attribute__((ext_vector_type(2)));
typedef __bf16 bf16x2v __attribute__((ext_vector_type(2)));
DEVI bf16 f2bf(float f) { __bf16 r = (__bf16)f; return __builtin_bit_cast(unsigned short, r); }
DEVI float bf2f(bf16 h) { return __uint_as_float(((unsigned)h) << 16); }
DEVI unsigned pack2(float a, float b) {
  f32x2 v = {a, b};
  bf16x2v r = __builtin_convertvector(v, bf16x2v);
  return __builtin_bit_cast(unsigned, r);
}
DEVI float bflo(unsigned u) { return __uint_as_float(u << 16); }
DEVI float bfhi(unsigned u) { return __uint_as_float(u & 0xffff0000u); }
DEVI float siluf(float x) { return x * __builtin_amdgcn_rcpf(1.f + __expf(-x)); }
DEVI float sigmf(float x) { return __builtin_amdgcn_rcpf(1.f + __expf(-x)); }
DEVI float softplusf(float x) { return x > 20.f ? x : __logf(1.f + __expf(x)); }
DEVI float tanhfast(float x) { return 1.f - 2.f / (__expf(2.f * x) + 1.f); }
DEVI float wave_sum(float v) {
#pragma unroll
  for (int d = 32; d >= 1; d >>= 1) v += __shfl_xor(v, d);
  return v;
}
DEVI f32x16 mfma32(bf16x8 a, bf16x8 b, f32x16 c) { return __builtin_amdgcn_mfma_f32_32x32x16_bf16(a, b, c, 0, 0, 0); }
DEVI f32x16 zero16() {
  f32x16 z;
#pragma unroll
  for (int i = 0; i < 16; ++i) z[i] = 0.f;
  return z;
}
DEVI int accrow(int r, int lane) { return (r & 3) + 8 * (r >> 2) + 4 * (lane >> 5); }

template <int CTRL, int RM>
DEVI float dpp_add(float x) {
  int y = __builtin_amdgcn_update_dpp(0, __float_as_int(x), CTRL, RM, 0xf, true);
  return x + __int_as_float(y);
}
DEVI float wave_sum63(float x) {
  x = dpp_add<0xB1, 0xf>(x);
  x = dpp_add<0x4E, 0xf>(x);
  x = dpp_add<0x141, 0xf>(x);
  x = dpp_add<0x140, 0xf>(x);
  x = dpp_add<0x142, 0xa>(x);
  x = dpp_add<0x143, 0xc>(x);
  return __int_as_float(__builtin_amdgcn_readlane(__float_as_int(x), 63));
}

DEVI f32x16 mma_lds(const bf16* As, int lda, const bf16* Bs, int ldb, int K, f32x16 acc, int lane) {
  const bf16* ap = As + (lane & 31) * lda + (lane >> 5) * 8;
  const bf16* bp = Bs + (lane & 31) * ldb + (lane >> 5) * 8;
#pragma unroll 4
  for (int k = 0; k < K; k += 16) {
    acc = mfma32(*(const bf16x8*)(ap + k), *(const bf16x8*)(bp + k), acc);
    if ((k & 48) == 48) __builtin_amdgcn_sched_barrier(0);
  }
  return acc;
}


constexpr int GB_XCNT = 128, GB_XARR = 1280, GB_TOP = 2432, GB_TOPGEN = 2496, GB_XGEN = 2560;
DEVI unsigned ld_agent(unsigned* q) { return __hip_atomic_load(q, __ATOMIC_RELAXED, __HIP_MEMORY_SCOPE_AGENT); }
DEVI unsigned add_agent(unsigned* q, unsigned v) { return __hip_atomic_fetch_add(q, v, __ATOMIC_RELAXED, __HIP_MEMORY_SCOPE_AGENT); }
DEVI unsigned xcc_id() { return (unsigned)__builtin_amdgcn_s_getreg((3 << 11) | 20) & 0xFu; }
DEVI void gb_spin(unsigned* q, unsigned g) {
  unsigned sp = 0;
  while (ld_agent(q) < g) {
    __builtin_amdgcn_s_sleep(1);
    if (++sp > (1u << 22)) break;
  }
}
DEVI void gbar(unsigned* w, unsigned x, unsigned ncnt, unsigned nx, unsigned g) {
  asm volatile("s_waitcnt vmcnt(0) lgkmcnt(0)" ::: "memory");
  __syncthreads();
  if (threadIdx.x == 0) {
    const unsigned a = add_agent(&w[GB_XARR + 64 * x], 1u) + 1u;
    if (a == g * ncnt) {
      __builtin_amdgcn_fence(__ATOMIC_RELEASE, "agent");
      asm volatile("s_waitcnt vmcnt(0)" ::: "memory");
      const unsigned t = add_agent(&w[GB_TOP], 1u) + 1u;
      if (t == g * nx) __hip_atomic_store(&w[GB_TOPGEN], g, __ATOMIC_RELAXED, __HIP_MEMORY_SCOPE_AGENT);
      else gb_spin(&w[GB_TOPGEN], g);
      __builtin_amdgcn_fence(__ATOMIC_ACQUIRE, "agent");
      __hip_atomic_store(&w[GB_XGEN + 64 * x], g, __ATOMIC_RELAXED, __HIP_MEMORY_SCOPE_AGENT);
      asm volatile("s_waitcnt vmcnt(0)" ::: "memory");
    } else {
      gb_spin(&w[GB_XGEN + 64 * x], g);
      __builtin_amdgcn_fence(__ATOMIC_ACQUIRE, "agent");
      asm volatile("s_waitcnt vmcnt(0)" ::: "memory");
    }
  }
  __syncthreads();
}

enum {
  EPI_SSD_IN = 0, EPI_RESID, EPI_GU, EPI_QKV, EPI_F32, EPI_RK_W1, EPI_RK_A1, EPI_RK_G1, EPI_RK_W2, EPI_RK_A2, EPI_RESID_TAIL, EPI_BF16
};
struct GJob {
  const bf16* A;
  const bf16* Bt;
  int lda, K, epi, aux;
  float* of;
};

DEVI void gemm_epi_ssd_in(const Params& p, f32x16 (&acc)[2][2], int rbase, int cbase, int lane) {
  char* ar = PW(char, W_arena);
  const int d = lane & 31;
  if (cbase < 6144) {
    const bool isz = cbase < 2048;
    const int ld = isz ? 2048 : 4096;
    bf16* dst = (isz ? (bf16*)(ar + S_ZB) + cbase : (bf16*)(ar + S_XBC) + (cbase - 2048)) + d;
#pragma unroll
    for (int i = 0; i < 2; ++i)
#pragma unroll
      for (int r = 0; r < 16; ++r) {
        const int row = rbase + i * 32 + accrow(r, lane);
        if (row < M) {
          bf16* q = dst + (size_t)row * ld;
          q[0] = f2bf(acc[i][0][r]);
          q[32] = f2bf(acc[i][1][r]);
        }
      }
  } else {
    float* dtr = (float*)(ar + S_DTRAW);
#pragma unroll
    for (int i = 0; i < 2; ++i)
#pragma unroll
      for (int r = 0; r < 16; ++r) {
        const int row = rbase + i * 32 + accrow(r, lane);
        if (row < M && cbase == 6144) dtr[(size_t)row * 32 + d] = acc[i][0][r];
      }
  }
}

DEVI void gemm_epi_qkv(const Params& p, f32x16 (&acc)[2][2], int rbase, int cbase, int lane) {
  char* ar = PW(char, W_arena);
  const int which = cbase >> 10, cc = cbase & 1023, d = lane & 31, hl = lane >> 5;
#pragma unroll
  for (int i = 0; i < 2; ++i) {
#pragma unroll
    for (int rq = 0; rq < 4; ++rq) {
      const int row0 = rbase + i * 32 + 8 * rq + 4 * hl;
      if (row0 >= M) continue;
      const bool pr = row0 < TP;
      const int b = pr ? 0 : (row0 - TP) >> 4, t0 = pr ? row0 : (row0 - TP) & 15;
      if (which < 2) {
        const float* csp = PW(float, W_cs) + (size_t)row0 * 64 + d;
        bf16* dst;
        float* fo = nullptr;
        if (which == 0) dst = (bf16*)(ar + A_QB) + (size_t)row0 * 1024 + cc + d;
        else {
          const size_t ur = pr ? (size_t)(48 + row0) : (size_t)(LDVP + b * LDVS + 48 + 4096 + t0);
          dst = (bf16*)(ar + A_KALL) + ur * 1024 + cc + d;
          fo = (pr ? POUT + O_KP + (size_t)row0 * 1024 : POUT + O_KS + (size_t)(row0 - TP) * 1024) + cc + d;
        }
#pragma unroll
        for (int rr = 0; rr < 4; ++rr) {
          const float x1 = acc[i][0][rq * 4 + rr], x2 = acc[i][1][rq * 4 + rr];
          const float c = csp[rr * 64], s = csp[rr * 64 + 32];
          const float o1 = x1 * c - x2 * s, o2 = x2 * c + x1 * s;
          dst[rr * 1024] = f2bf(o1);
          dst[rr * 1024 + 32] = f2bf(o2);
          if (which == 1) { fo[rr * 1024] = o1; fo[rr * 1024 + 32] = o2; }
        }
      } else {
        float* vo = (pr ? POUT + O_VP + (size_t)row0 * 1024 : POUT + O_VS + (size_t)(row0 - TP) * 1024) + cc + d;
#pragma unroll
        for (int rr = 0; rr < 4; ++rr) {
          vo[rr * 1024] = acc[i][0][rq * 4 + rr];
          vo[rr * 1024 + 32] = acc[i][1][rq * 4 + rr];
        }
        const int h = cc >> 7, e = (cc & 127) + d;
        bf16* vt = pr ? (bf16*)(ar + A_VTP) + (size_t)(h * 128 + e) * LDVP + 48 + row0
                      : (bf16*)(ar + A_VTS) + (size_t)((b * 8 + h) * 128 + e) * LDVS + 48 + 4096 + t0;
        const size_t ld = pr ? LDVP : LDVS;
        uint2 o1, o2;
        o1.x = pack2(acc[i][0][rq * 4 + 0], acc[i][0][rq * 4 + 1]); o1.y = pack2(acc[i][0][rq * 4 + 2], acc[i][0][rq * 4 + 3]);
        o2.x = pack2(acc[i][1][rq * 4 + 0], acc[i][1][rq * 4 + 1]); o2.y = pack2(acc[i][1][rq * 4 + 2], acc[i][1][rq * 4 + 3]);
        *(uint2*)vt = o1;
        *(uint2*)(vt + 32 * ld) = o2;
      }
    }
  }
}

template <int EPI>
DEVI void gemm_epi(const Params& p, const GJob& jb, f32x16 (&acc)[2][2], int rbase, int cbase, int lane) {
  const float* i_rk_w0 = PIN(23);
  const float* i_rk_a0 = PIN(26);
  char* ar = PW(char, W_arena);
#pragma unroll
  for (int i = 0; i < 2; ++i) {
#pragma unroll
    for (int r = 0; r < 16; ++r) {
      const int row = rbase + i * 32 + accrow(r, lane);
      if (row < M) {
#pragma unroll
        for (int j = 0; j < 2; ++j) {
          const int col = cbase + j * 32 + (lane & 31);
          const float v = acc[i][j][r];
          if (EPI == EPI_SSD_IN) {
            if (col < 2048) ((bf16*)(ar + S_ZB))[(size_t)row * 2048 + col] = f2bf(v);
            else if (col < 6144) ((bf16*)(ar + S_XBC))[(size_t)row * 4096 + col - 2048] = f2bf(v);
            else if (col < 6176) ((float*)(ar + S_DTRAW))[(size_t)row * 32 + col - 6144] = v;
          } else if (EPI == EPI_RESID) {
            PW(bf16, W_Z)[(size_t)row * 1024 + col] = f2bf(ALPHA * bf2f(PW(bf16, W_Xb)[(size_t)row * 1024 + col]) + v);
          } else if (EPI == EPI_GU) {
            ((bf16*)(ar + F_GU))[(size_t)row * 5632 + col] = f2bf(v);
          } else if (EPI == EPI_BF16) {
            ((bf16*)jb.of)[(size_t)row * 1024 + col] = f2bf(v);
          } else if (EPI == EPI_F32) {
            jb.of[(size_t)row * 1024 + col] = v;
          } else if (EPI == EPI_RK_W1) {
            if (col < 64) ((bf16*)(ar + R_HW))[(size_t)row * 64 + col] = f2bf(tanhfast(v));
          } else if (EPI == EPI_RK_A1) {
            if (col < 64) ((bf16*)(ar + R_HA))[(size_t)row * 64 + col] = f2bf(v);
          } else if (EPI == EPI_RK_G1) {
            if (col < 192) ((bf16*)(ar + R_HG))[(size_t)row * 192 + col] = f2bf(col < 160 ? sigmf(v) : 0.f);
          } else if (EPI == EPI_RK_W2) {
            const float z = i_rk_w0[col] + v;
            const float wl = -softplusf(-z) - 0.5f;
            ((float*)(ar + R_W))[(size_t)row * 1024 + col] = __expf(-__expf(wl));
          } else if (EPI == EPI_RESID_TAIL) {
            atomicAdd(PW(float, W_ZT) + (size_t)(row - 16384) * 1024 + col, v);
          } else if (EPI == EPI_RK_A2) {
            ((bf16*)(ar + R_A))[(size_t)row * 1024 + col] = f2bf(sigmf(i_rk_a0[col] + v));
          }
        }
      }
    }
  }
}

DEVI void gemm_epi_gu(const Params& p, const GJob& jb, f32x16 (&acc)[2][2], int m0, int cbase, int wm, int wn, int lane, char* smem) {
  const float* i_state_ffn_conv = PIN(8);
  const float* i_ffn_conv_w = PIN(42);
  const float* i_ffn_conv_b = PIN(43);
  const int layer = jb.aux;
  float* Gs = (float*)smem;
  const int col = wn * 32 + (lane & 31);
#pragma unroll
  for (int i = 0; i < 2; ++i)
#pragma unroll
    for (int r = 0; r < 16; ++r) Gs[(wm * 64 + i * 32 + accrow(r, lane)) * 64 + col] = acc[i][0][r];
  __syncthreads();
  const int c = (cbase >> 6) * 32 + (lane & 31);
  const float w0 = i_ffn_conv_w[(size_t)layer * 3 * 2816 + c], w1 = i_ffn_conv_w[(size_t)layer * 3 * 2816 + 2816 + c];
  const float w2 = i_ffn_conv_w[(size_t)layer * 3 * 2816 + 2 * 2816 + c], cb = i_ffn_conv_b[(size_t)layer * 2816 + c];
  bf16* Hb = (bf16*)(PW(char, W_arena) + F_HB);
  float* outp = POUT;
  if (m0 >= 0 && m0 + 128 <= TP - 2) {
    bf16* hrow = Hb + (size_t)m0 * 2816 + c;
#pragma unroll
    for (int i = 0; i < 2; ++i) {
#pragma unroll
      for (int r = 0; r < 16; ++r) {
        const int trow = wm * 64 + i * 32 + accrow(r, lane);
        if (trow >= 2) {
          const float cv = cb + w0 * Gs[(trow - 2) * 64 + col] + w1 * Gs[(trow - 1) * 64 + col] + w2 * acc[i][0][r];
          hrow[(size_t)trow * 2816] = f2bf(siluf(cv) * acc[i][1][r]);
        }
      }
    }
    __syncthreads();
    return;
  }
#pragma unroll
  for (int i = 0; i < 2; ++i) {
#pragma unroll
    for (int r = 0; r < 16; ++r) {
      const int trow = wm * 64 + i * 32 + accrow(r, lane);
      const int m = m0 + trow;
      if (trow >= 2 && m < M) {
        int b = -1, t = m, L = TP;
        if (m >= TP) { b = (m - TP) >> 4; t = (m - TP) & 15; L = 16; }
        const float g2 = acc[i][0][r];
        float g1, g0;
        if (t >= 1) g1 = Gs[(trow - 1) * 64 + col];
        else g1 = (b >= 0) ? i_state_ffn_conv[((size_t)(layer * 16 + b) * 2 + 1) * 2816 + c] : 0.f;
        if (t >= 2) g0 = Gs[(trow - 2) * 64 + col];
        else g0 = (b >= 0) ? i_state_ffn_conv[((size_t)(layer * 16 + b) * 2 + t) * 2816 + c] : 0.f;
        const float cv = cb + w0 * g0 + w1 * g1 + w2 * g2;
        Hb[(size_t)m * 2816 + c] = f2bf(siluf(cv) * acc[i][1][r]);
        if (t >= L - 2) {
          float* so = (b < 0) ? outp + O_FCP + ((size_t)layer * 2 + (t - (L - 2))) * 2816 + c
                              : outp + O_FCS + ((size_t)(layer * 16 + b) * 2 + (t - (L - 2))) * 2816 + c;
          *so = g2;
        }
      }
    }
  }
  __syncthreads();
}

DEVI void gemm_tile(const Params& p, const GJob& jb, int m0, int n0, char* smem, int kt0 = 0, int kt1 = -1) {
  bf16* As = (bf16*)smem;
  bf16* Bs = As + 128 * 72;
  const int tid = TID(), lane = tid & 63, wave = tid >> 6, wm = wave >> 1, wn = wave & 1;
  f32x16 acc[2][2];
#pragma unroll
  for (int i = 0; i < 2; ++i)
#pragma unroll
    for (int j = 0; j < 2; ++j) acc[i][j] = zero16();
  const int lrow = tid >> 3, lkc = (tid & 7) * 8;
  const bf16* Ag = jb.A + (size_t)max(m0 + lrow, 0) * jb.lda + lkc;
  const bf16* Ag1 = jb.A + (ptrdiff_t)(m0 + lrow) * jb.lda + lkc;
  const bf16* Bg = jb.Bt + (size_t)(n0 + lrow) * jb.K + lkc;
  const size_t astep = (size_t)32 * jb.lda, bstep = (size_t)32 * jb.K;
  if (kt1 < 0) kt1 = jb.K >> 6;
  const int nk = kt1 - kt0;
  Ag += (size_t)kt0 * 64; Ag1 += (size_t)kt0 * 64; Bg += (size_t)kt0 * 64;
  u32x4 ra0[4], rb0[4], ra1[4], rb1[4];
#define G_LOAD(RA, RB, kt_)                                                  \
  {                                                                          \
    _Pragma("unroll") for (int i = 0; i < 4; ++i) {                          \
      RA[i] = *(const u32x4*)((i == 0 ? Ag : Ag1) + i * astep + (size_t)(kt_) * 64); \
      RB[i] = *(const u32x4*)(Bg + i * bstep + (size_t)(kt_) * 64);          \
    }                                                                        \
  }
#define G_STORE(RA, RB, AS_, BS_)                                            \
  {                                                                          \
    _Pragma("unroll") for (int i = 0; i < 4; ++i) {                          \
      *(u32x4*)(AS_ + (lrow + 32 * i) * 72 + lkc) = RA[i];                   \
      *(u32x4*)(BS_ + (lrow + 32 * i) * 72 + lkc) = RB[i];                   \
    }                                                                        \
  }
#define G_COMPUTE(AS_, BS_)                                                                                     \
  {                                                                                                             \
    _Pragma("unroll") for (int ks = 0; ks < 4; ++ks) {                                                          \
      bf16x8 a[2], b[2];                                                                                        \
      _Pragma("unroll") for (int i = 0; i < 2; ++i)                                                             \
        a[i] = *(const bf16x8*)(AS_ + (wm * 64 + i * 32 + (lane & 31)) * 72 + ks * 16 + (lane >> 5) * 8);       \
      _Pragma("unroll") for (int j = 0; j < 2; ++j)                                                             \
        b[j] = *(const bf16x8*)(BS_ + (wn * 64 + j * 32 + (lane & 31)) * 72 + ks * 16 + (lane >> 5) * 8);       \
      _Pragma("unroll") for (int i = 0; i < 2; ++i)                                                             \
        _Pragma("unroll") for (int j = 0; j < 2; ++j) acc[i][j] = mfma32(a[i], b[j], acc[i][j]);                \
    }                                                                                                           \
  }
  bf16* As1 = As + 2 * 128 * 72;
  bf16* Bs1 = As1 + 128 * 72;
  G_LOAD(ra0, rb0, 0);
  if (nk > 1) G_LOAD(ra1, rb1, 1);
  G_STORE(ra0, rb0, As, Bs);
  __syncthreads();
  for (int kt = 0; kt < nk; kt += 2) {
    if (kt + 2 < nk) G_LOAD(ra0, rb0, kt + 2);
    if (kt + 1 < nk) G_STORE(ra1, rb1, As1, Bs1);
    G_COMPUTE(As, Bs);
    __syncthreads();
    if (kt + 1 < nk) {
      if (kt + 3 < nk) G_LOAD(ra1, rb1, kt + 3);
      if (kt + 2 < nk) G_STORE(ra0, rb0, As, Bs);
      G_COMPUTE(As1, Bs1);
      __syncthreads();
    }
  }
#undef G_LOAD
#undef G_STORE
#undef G_COMPUTE
  const int rbase = m0 + wm * 64, cbase = n0 + wn * 64;
  switch (jb.epi) {
    case EPI_SSD_IN: gemm_epi_ssd_in(p, acc, rbase, cbase, lane); break;
    case EPI_RESID: gemm_epi<EPI_RESID>(p, jb, acc, rbase, cbase, lane); break;
    case EPI_GU: gemm_epi_gu(p, jb, acc, m0, cbase, wm, wn, lane, smem); break;
    case EPI_QKV: gemm_epi_qkv(p, acc, rbase, cbase, lane); break;
    case EPI_F32: gemm_epi<EPI_F32>(p, jb, acc, rbase, cbase, lane); break;
    case EPI_BF16: gemm_epi<EPI_BF16>(p, jb, acc, rbase, cbase, lane); break;
    case EPI_RK_W1: gemm_epi<EPI_RK_W1>(p, jb, acc, rbase, cbase, lane); break;
    case EPI_RK_A1: gemm_epi<EPI_RK_A1>(p, jb, acc, rbase, cbase, lane); break;
    case EPI_RK_G1: gemm_epi<EPI_RK_G1>(p, jb, acc, rbase, cbase, lane); break;
    case EPI_RK_W2: gemm_epi<EPI_RK_W2>(p, jb, acc, rbase, cbase, lane); break;
    case EPI_RESID_TAIL: gemm_epi<EPI_RESID_TAIL>(p, jb, acc, rbase, cbase, lane); break;
    default: gemm_epi<EPI_RK_A2>(p, jb, acc, rbase, cbase, lane); break;
  }
}

DEVI void tile_decode(int id, int nttot, int& mt, int& ntg, int mtn = MT) {
  const int per = 16 * nttot;
  const int g = id / per, r = id - g * per;
  const int gsz = min(16, mtn - g * 16);
  mt = g * 16 + r % gsz;
  ntg = r / gsz;
}

DEVI void gemm_single(const Params& p, const GJob& jb, int nt, char* smem) {
  const bool fused = (jb.epi == EPI_GU);
  const int mtn = fused ? 133 : MT;
  if (nt >= 16 && (gridDim.x & 7) == 0) {
    const int b = BID(), x = b & 7, lb = b >> 3, nlb = gridDim.x >> 3;
    const int ng = x & 3, mh = x >> 2;
    const int n_lo = ng * nt / 4, nnt = (ng + 1) * nt / 4 - n_lo;
    const int m_lo = mh * mtn / 2, nmt = (mh + 1) * mtn / 2 - m_lo;
    for (int t = lb; t < nmt * nnt; t += nlb) {
      const int mt = m_lo + t / nnt, ntg = n_lo + t % nnt;
      gemm_tile(p, jb, fused ? mt * 126 - 2 : mt * 128, ntg * 128, smem);
    }
    return;
  }
  if (jb.epi == EPI_RESID && nt == 8) {
    for (int id = BID(); id < 1024; id += gridDim.x) {
      int mt, ntg;
      tile_decode(id, 8, mt, ntg, 128);
      gemm_tile(p, jb, mt * 128, ntg * 128, smem);
    }
    const int nkt = jb.K >> 6;
    const int S = max(1, min(nkt, (int)gridDim.x / 24));
    GJob jt = jb;
    jt.epi = EPI_RESID_TAIL;
    for (int u = BID(); u < 24 * S; u += gridDim.x) {
      const int tile = u / S, c = u - tile * S;
      gemm_tile(p, jt, (128 + (tile >> 3)) * 128, (tile & 7) * 128, smem, c * nkt / S, (c + 1) * nkt / S);
    }
    return;
  }
  const int total = mtn * nt;
  for (int id = BID(); id < total; id += gridDim.x) {
    int mt, ntg;
    tile_decode(id, nt, mt, ntg, mtn);
    gemm_tile(p, jb, fused ? mt * 126 - 2 : mt * 128, ntg * 128, smem);
  }
}

DEVI void tjob(const Params& p, int j, const float*& src, bf16*& dst, int& K, int& N, int& Kp, int& Np, int& rmap) {
  rmap = (j >= 16 && j < 20) ? 1 : (j >= 20 && j < 24) ? 2 : 0;
  const float* i_ssd_w_in = PIN(10);
  const float* i_ssd_w_out = PIN(17);
  const float* i_da_w_qkv = PIN(18);
  const float* i_da_w_o = PIN(21);
  const float* i_rk_w_r = PIN(34);
  const float* i_rk_w_k = PIN(35);
  const float* i_rk_w_v = PIN(36);
  const float* i_rk_w_o = PIN(37);
  const float* i_rk_w1 = PIN(24);
  const float* i_rk_a1 = PIN(27);
  const float* i_rk_g1 = PIN(29);
  const float* i_rk_w2 = PIN(25);
  const float* i_rk_a2 = PIN(28);
  const float* i_rk_g2 = PIN(30);
  const float* i_ffn_w_gate = PIN(41);
  const float* i_ffn_w_up = PIN(40);
  const float* i_ffn_w_down = PIN(44);
  if (j < 2) { src = i_ssd_w_in + (size_t)j * 1024 * 6176; dst = PW(bf16, W_wt_ssd_in) + (size_t)j * 6272 * 1024; K = 1024; N = 6176; Kp = 1024; Np = 6272; }
  else if (j < 4) { src = i_ssd_w_out + (size_t)(j - 2) * 2048 * 1024; dst = PW(bf16, W_wt_ssd_out) + (size_t)(j - 2) * 1024 * 2048; K = 2048; N = 1024; Kp = 2048; Np = 1024; }
  else if (j == 4) { src = i_da_w_qkv; dst = PW(bf16, W_wt_qkv); K = 1024; N = 3072; Kp = 1024; Np = 3072; }
  else if (j < 10) {
    K = 1024; N = 1024; Kp = 1024; Np = 1024;
    if (j == 5) { src = i_da_w_o; dst = PW(bf16, W_wt_o); }
    else if (j == 6) { src = i_rk_w_r; dst = PW(bf16, W_wt_r); }
    else if (j == 7) { src = i_rk_w_k; dst = PW(bf16, W_wt_k); }
    else if (j == 8) { src = i_rk_w_v; dst = PW(bf16, W_wt_v); }
    else { src = i_rk_w_o; dst = PW(bf16, W_wt_ro); }
  }
  else if (j == 10) { src = i_rk_w1; dst = PW(bf16, W_wt_w1); K = 1024; N = 64; Kp = 1024; Np = 128; }
  else if (j == 11) { src = i_rk_a1; dst = PW(bf16, W_wt_a1); K = 1024; N = 64; Kp = 1024; Np = 128; }
  else if (j == 12) { src = i_rk_g1; dst = PW(bf16, W_wt_g1); K = 1024; N = 160; Kp = 1024; Np = 256; }
  else if (j == 13) { src = i_rk_w2; dst = PW(bf16, W_wt_w2); K = 64; N = 1024; Kp = 64; Np = 1024; }
  else if (j == 14) { src = i_rk_a2; dst = PW(bf16, W_wt_a2); K = 64; N = 1024; Kp = 64; Np = 1024; }
  else if (j == 15) { src = i_rk_g2; dst = PW(bf16, W_wt_g2); K = 160; N = 1024; Kp = 192; Np = 1024; }
  else if (j < 20) { src = i_ffn_w_gate + (size_t)(j - 16) * 1024 * 2816; dst = PW(bf16, W_wt_gu) + (size_t)(j - 16) * 5632 * 1024; K = 1024; N = 2816; Kp = 1024; Np = 2816; }
  else if (j < 24) { src = i_ffn_w_up + (size_t)(j - 20) * 1024 * 2816; dst = PW(bf16, W_wt_gu) + (size_t)(j - 20) * 5632 * 1024; K = 1024; N = 2816; Kp = 1024; Np = 2816; }
  else { src = i_ffn_w_down + (size_t)(j - 24) * 2816 * 1024; dst = PW(bf16, W_wt_down) + (size_t)(j - 24) * 1024 * 2816; K = 2816; N = 1024; Kp = 2816; Np = 1024; }
}

DEVI int tjob_group(int j) {
  if (j == 1 || j == 3 || j == 18 || j == 19 || j == 22 || j == 23 || j == 26 || j == 27) return 2;
  if (j == 0 || j == 2 || j == 16 || j == 20 || j == 24) return 0;
  return 1;
}

DEVI void convert_weights(const Params& p, char* smem, int group, int vb, int nvb) {
  const int tid = TID();
  float* tile = (float*)smem;
  int base = 0;
  for (int j = 0; j < 28; ++j) {
    if (tjob_group(j) != group) continue;
    const float* src; bf16* dst; int K, N, Kp, Np, rmap;
    tjob(p, j, src, dst, K, N, Kp, Np, rmap);
    const int tn_n = Np >> 6, nt = (Kp >> 6) * tn_n;
    int first = (vb - base % nvb + nvb) % nvb;
    for (int t = first; t < nt; t += nvb) {
      const int tk = t / tn_n, tn = t - tk * tn_n;
      for (int e = tid; e < 4096; e += 256) {
        const int i = e >> 6, jj = e & 63, k = tk * 64 + i, n = tn * 64 + jj;
        tile[i * 65 + jj] = (k < K && n < N) ? src[(size_t)k * N + n] : 0.f;
      }
      __syncthreads();
      for (int e = tid; e < 2048; e += 256) {
        const int i = e >> 5, j2 = (e & 31) * 2;
        const unsigned v = pack2(tile[j2 * 65 + i], tile[(j2 + 1) * 65 + i]);
        const int nrow = tn * 64 + i;
        const int drow = (rmap == 0) ? nrow : ((nrow >> 5) * 64 + (nrow & 31) + (rmap == 2 ? 32 : 0));
        *(unsigned*)(dst + (size_t)drow * Kp + tk * 64 + j2) = v;
      }
      __syncthreads();
    }
    base += nt;
  }
}

DEVI void phase_prep(const Params& p, char* smem) {
  const float* i_meta = PIN(9);
  const float* i_x_prompt = PIN(0);
  const float* i_x_sample = PIN(1);
  const int tid = TID(), G = gridDim.x;
  const size_t gtid = (size_t)BID() * 256 + tid, nth = (size_t)G * 256;
  convert_weights(p, smem, 0, BID(), G);
  for (size_t i0 = gtid; i0 < (size_t)M * 256; i0 += nth * 4) {
    float4 v[4];
#pragma unroll
    for (int u = 0; u < 4; ++u) {
      const size_t idx = i0 + u * nth;
      if (idx < (size_t)M * 256) {
        const int m = (int)(idx >> 8), c4 = (int)(idx & 255) * 4;
        const float* src = (m < 16) ? i_meta + (size_t)m * 1024
                                    : (m < TP) ? i_x_prompt + (size_t)(m - 16) * 1024 : i_x_sample + (size_t)(m - TP) * 1024;
        v[u] = *(const float4*)(src + c4);
      }
    }
#pragma unroll
    for (int u = 0; u < 4; ++u) {
      const size_t idx = i0 + u * nth;
      if (idx < (size_t)M * 256) {
        const int m = (int)(idx >> 8), c4 = (int)(idx & 255) * 4;
        uint2 o; o.x = pack2(v[u].x, v[u].y); o.y = pack2(v[u].z, v[u].w);
        *(uint2*)(PW(bf16, W_Xb) + (size_t)m * 1024 + c4) = o;
      }
    }
  }
  for (size_t idx = gtid; idx < (size_t)384 * 256; idx += nth) *(float4*)(PW(float, W_ZT) + idx * 4) = make_float4(0.f, 0.f, 0.f, 0.f);
  for (size_t idx = gtid; idx < (size_t)M * 32; idx += nth) {
    const int m = (int)(idx >> 5), d = (int)(idx & 31);
    const float pos = (m < TP) ? (float)m : (float)(4096 + ((m - TP) & 15));
    const float inv = __builtin_amdgcn_exp2f(-(float)d * (13.287712379549449f / 32.f));
    float tr = (pos * inv) * 0.15915494309189535f;
    tr -= floorf(tr);
    PW(float, W_cs)[(size_t)m * 64 + d] = __builtin_amdgcn_cosf(tr);
    PW(float, W_cs)[(size_t)m * 64 + 32 + d] = __builtin_amdgcn_sinf(tr);
  }
}

DEVI void phase_ln(const Params& p, int li, bool final_) {
  const float* i_ln_g = PIN(45);
  const float* i_ln_b = PIN(46);
  const int lane = TID() & 63;
  const int gw = BID() * 4 + (TID() >> 6), nw = gridDim.x * 4;
  const float* g = i_ln_g + (size_t)li * 1024;
  const float* b = i_ln_b + (size_t)li * 1024;
  float4 ggr[4], bbr[4];
#pragma unroll
  for (int i = 0; i < 4; ++i) {
    ggr[i] = *(const float4*)(g + (i * 64 + lane) * 4);
    bbr[i] = *(const float4*)(b + (i * 64 + lane) * 4);
  }
  for (int m = gw; m < M; m += nw) {
    const bf16* z = PW(bf16, W_Z) + (size_t)m * 1024;
    f32x4 v[4];
    float s = 0.f;
    if (m < 16384) {
#pragma unroll
      for (int i = 0; i < 4; ++i) {
        const uint2 zz = *(const uint2*)(z + (i * 64 + lane) * 4);
        v[i] = f32x4{bflo(zz.x), bfhi(zz.x), bflo(zz.y), bfhi(zz.y)};
      }
    } else {
      float* zt = PW(float, W_ZT) + (size_t)(m - 16384) * 1024;
      const bf16* xo = PW(bf16, W_Xb) + (size_t)m * 1024;
#pragma unroll
      for (int i = 0; i < 4; ++i) {
        const int c = (i * 64 + lane) * 4;
        const uint2 xx = *(const uint2*)(xo + c);
        const f32x4 t = *(const f32x4*)(zt + c);
        v[i] = f32x4{ALPHA * bflo(xx.x) + t.x, ALPHA * bfhi(xx.x) + t.y, ALPHA * bflo(xx.y) + t.z, ALPHA * bfhi(xx.y) + t.w};
        *(f32x4*)(zt + c) = f32x4{0.f, 0.f, 0.f, 0.f};
      }
    }
#pragma unroll
    for (int i = 0; i < 4; ++i) s += v[i].x + v[i].y + v[i].z + v[i].w;
    const float mean = wave_sum(s) * (1.f / 1024.f);
    float q = 0.f;
#pragma unroll
    for (int i = 0; i < 4; ++i) {
      v[i].x -= mean; v[i].y -= mean; v[i].z -= mean; v[i].w -= mean;
      q += v[i].x * v[i].x + v[i].y * v[i].y + v[i].z * v[i].z + v[i].w * v[i].w;
    }
    const float rstd = rsqrtf(wave_sum(q) * (1.f / 1024.f) + 1e-5f);
#pragma unroll
    for (int i = 0; i < 4; ++i) {
      const int c = (i * 64 + lane) * 4;
      const float4 gg = ggr[i], bb = bbr[i];
      float4 o;
      o.x = v[i].x * rstd * gg.x + bb.x; o.y = v[i].y * rstd * gg.y + bb.y;
      o.z = v[i].z * rstd * gg.z + bb.z; o.w = v[i].w * rstd * gg.w + bb.w;
      uint2 ob; ob.x = pack2(o.x, o.y); ob.y = pack2(o.z, o.w);
      *(uint2*)(PW(bf16, W_Xb) + (size_t)m * 1024 + c) = ob;
      if (final_) {
        if (m >= TP) *(float4*)(POUT + O_YS + (size_t)(m - TP) * 1024 + c) = o;
        else if (m >= 16) *(float4*)(POUT + O_YP + (size_t)(m - 16) * 1024 + c) = o;
      }
    }
  }
}

DEVI void phase_ffn_e(const Params& p, int layer) {
  const float* i_state_ffn_conv = PIN(8);
  const float* i_ffn_conv_w = PIN(42);
  const float* i_ffn_conv_b = PIN(43);
  const size_t gtid = (size_t)BID() * 256 + TID(), nth = (size_t)gridDim.x * 256;
  const bf16* GU = (const bf16*)(PW(char, W_arena) + F_GU);
  bf16* Hb = (bf16*)(PW(char, W_arena) + F_HB);
  float* outp = POUT;
  const float* cw = i_ffn_conv_w + (size_t)layer * 3 * 2816;
  const float* cb = i_ffn_conv_b + (size_t)layer * 2816;
  for (size_t idx = gtid; idx < (size_t)(M / 16) * 352; idx += nth) {
    const int rb = (int)(idx / 352), c = (int)(idx - (size_t)rb * 352) * 8;
    const int m0 = rb * 16;
    int b = -1, t0 = m0, L = TP;
    if (m0 >= TP) { b = (m0 - TP) >> 4; t0 = 0; L = 16; }
    float w0[8], w1[8], w2[8], bb[8], x0[8], x1[8];
#pragma unroll
    for (int e = 0; e < 8; ++e) {
      w0[e] = cw[c + e]; w1[e] = cw[2816 + c + e]; w2[e] = cw[2 * 2816 + c + e]; bb[e] = cb[c + e];
    }
    if (t0 >= 2) {
      const uint4 g0 = *(const uint4*)(GU + (size_t)(m0 - 2) * 5632 + c);
      const uint4 g1 = *(const uint4*)(GU + (size_t)(m0 - 1) * 5632 + c);
      x0[0] = bflo(g0.x); x0[1] = bfhi(g0.x); x0[2] = bflo(g0.y); x0[3] = bfhi(g0.y);
      x0[4] = bflo(g0.z); x0[5] = bfhi(g0.z); x0[6] = bflo(g0.w); x0[7] = bfhi(g0.w);
      x1[0] = bflo(g1.x); x1[1] = bfhi(g1.x); x1[2] = bflo(g1.y); x1[3] = bfhi(g1.y);
      x1[4] = bflo(g1.z); x1[5] = bfhi(g1.z); x1[6] = bflo(g1.w); x1[7] = bfhi(g1.w);
    } else {
#pragma unroll
      for (int e = 0; e < 8; ++e) {
        x0[e] = (b >= 0) ? i_state_ffn_conv[((size_t)(layer * 16 + b) * 2 + 0) * 2816 + c + e] : 0.f;
        x1[e] = (b >= 0) ? i_state_ffn_conv[((size_t)(layer * 16 + b) * 2 + 1) * 2816 + c + e] : 0.f;
      }
    }
    u32x4 gq[16], uq[16];
#pragma unroll
    for (int r = 0; r < 16; ++r) {
      gq[r] = *(const u32x4*)(GU + (size_t)(m0 + r) * 5632 + c);
      uq[r] = *(const u32x4*)(GU + (size_t)(m0 + r) * 5632 + 2816 + c);
    }
#pragma unroll
    for (int r = 0; r < 16; ++r) {
      float x2[8], u[8], h[8];
#pragma unroll
      for (int e = 0; e < 4; ++e) {
        x2[2 * e] = bflo(gq[r][e]); x2[2 * e + 1] = bfhi(gq[r][e]);
        u[2 * e] = bflo(uq[r][e]); u[2 * e + 1] = bfhi(uq[r][e]);
      }
#pragma unroll
      for (int e = 0; e < 8; ++e) {
        const float cv = bb[e] + w0[e] * x0[e] + w1[e] * x1[e] + w2[e] * x2[e];
        h[e] = siluf(cv) * u[e];
      }
      uint4 o;
      o.x = pack2(h[0], h[1]); o.y = pack2(h[2], h[3]); o.z = pack2(h[4], h[5]); o.w = pack2(h[6], h[7]);
      *(uint4*)(Hb + (size_t)(m0 + r) * 2816 + c) = o;
      const int t = t0 + r;
      if (t >= L - 2) {
        float* so = (b < 0) ? outp + O_FCP + ((size_t)layer * 2 + (t - (L - 2))) * 2816 + c
                            : outp + O_FCS + ((size_t)(layer * 16 + b) * 2 + (t - (L - 2))) * 2816 + c;
#pragma unroll
        for (int e = 0; e < 8; ++e) so[e] = x2[e];
      }
#pragma unroll
      for (int e = 0; e < 8; ++e) { x0[e] = x1[e]; x1[e] = x2[e]; }
    }
  }
}

DEVI void chunk_rows(int ci, int& r0, int& nv) {
  if (ci < 257) { r0 = ci * 64; nv = (ci == 256) ? 16 : 64; }
  else { r0 = TP + (ci - 257) * 16; nv = 16; }
}

DEVI void phase_ssd_e1(const Params& p, int jl, char* smem) {
  const float* i_ssd_conv_w = PIN(11);
  const float* i_ssd_conv_b = PIN(12);
  const float* i_state_ssd_conv = PIN(5);
  const float* i_ssd_dt_bias = PIN(13);
  char* ar = PW(char, W_arena);
  const bf16* xbc = (const bf16*)(ar + S_XBC);
  bf16* xc = (bf16*)(ar + S_XC);
  bf16* xT = (bf16*)(ar + S_XT);
  bf16* BT = (bf16*)(ar + S_BT);
  const float* cw = i_ssd_conv_w + (size_t)jl * 4 * 4096;
  const float* cbias = i_ssd_conv_b + (size_t)jl * 4096;
  bf16* T = (bf16*)smem;
  const int tid = TID();
  float wgt[4][16], bia[16];
  int cbw = -1;
  for (int tl = BID(); tl < NCH * 64; tl += gridDim.x) {
    const int ci = tl >> 6, cb = tl & 63;
    int r0, nv;
    chunk_rows(ci, r0, nv);
    const int l = tid >> 2, cq = (tid & 3) * 16;
    const int c0 = cb * 64 + cq;
    if (cb != cbw) {
      cbw = cb;
#pragma unroll
      for (int e = 0; e < 16; ++e) {
        bia[e] = cbias[c0 + e];
#pragma unroll
        for (int j = 0; j < 4; ++j) wgt[j][e] = cw[(size_t)j * 4096 + c0 + e];
      }
    }
    const int m = r0 + l;
    const bool valid = l < nv;
    const int b = (ci >= 257) ? ci - 257 : -1;
    const int t = (b >= 0) ? l : m;
    float o[16];
#pragma unroll
    for (int e = 0; e < 16; ++e) o[e] = 0.f;
    if (valid) {
#pragma unroll
      for (int e = 0; e < 16; ++e) o[e] = bia[e];
#pragma unroll
      for (int j = 0; j < 4; ++j) {
        const int tt = t - 3 + j;
        float xv[16];
        if (tt >= 0) {
          const uint4 a0 = *(const uint4*)(xbc + (size_t)(m - 3 + j) * 4096 + c0);
          const uint4 a1 = *(const uint4*)(xbc + (size_t)(m - 3 + j) * 4096 + c0 + 8);
          const unsigned a[8] = {a0.x, a0.y, a0.z, a0.w, a1.x, a1.y, a1.z, a1.w};
#pragma unroll
          for (int e = 0; e < 8; ++e) { xv[2 * e] = bflo(a[e]); xv[2 * e + 1] = bfhi(a[e]); }
        } else {
#pragma unroll
          for (int e = 0; e < 16; ++e)
            xv[e] = (b >= 0) ? i_state_ssd_conv[((size_t)(jl * 16 + b) * 3 + (tt + 3)) * 4096 + c0 + e] : 0.f;
        }
#pragma unroll
        for (int e = 0; e < 16; ++e) o[e] += wgt[j][e] * xv[e];
        if (j == 3 && ci >= 256 && l >= 13) {
          float* so = (b < 0) ? POUT + O_SCP + ((size_t)jl * 3 + (l - 13)) * 4096 + c0
                              : POUT + O_SCS + ((size_t)(jl * 16 + b) * 3 + (l - 13)) * 4096 + c0;
#pragma unroll
          for (int e = 0; e < 16; ++e) so[e] = xv[e];
        }
      }
#pragma unroll
      for (int e = 0; e < 16; ++e) o[e] = siluf(o[e]);
      uint4 w0, w1;
      w0.x = pack2(o[0], o[1]); w0.y = pack2(o[2], o[3]); w0.z = pack2(o[4], o[5]); w0.w = pack2(o[6], o[7]);
      w1.x = pack2(o[8], o[9]); w1.y = pack2(o[10], o[11]); w1.z = pack2(o[12], o[13]); w1.w = pack2(o[14], o[15]);
      *(uint4*)(xc + (size_t)m * 4096 + c0) = w0;
      *(uint4*)(xc + (size_t)m * 4096 + c0 + 8) = w1;
    }
    if (cb < 48) {
#pragma unroll
      for (int e = 0; e < 16; ++e) T[(cq + e) * 72 + l] = f2bf(o[e]);
      __syncthreads();
      const int cl = tid >> 2, lq = (tid & 3) * 16;
      const uint4 v0 = *(const uint4*)(T + cl * 72 + lq);
      const uint4 v1 = *(const uint4*)(T + cl * 72 + lq + 8);
      bf16* dst = (cb < 32) ? xT + ((size_t)ci * 2048 + cb * 64 + cl) * 64 + lq
                            : BT + ((size_t)ci * 1024 + (cb - 32) * 64 + cl) * 64 + lq;
      *(uint4*)dst = v0;
      *(uint4*)(dst + 8) = v1;
      __syncthreads();
    }
  }
  const float* dtraw = (const float*)(ar + S_DTRAW);
  float* dt = (float*)(ar + S_DT);
  for (size_t idx = (size_t)BID() * 256 + tid; idx < (size_t)M * 32; idx += (size_t)gridDim.x * 256)
    dt[idx] = softplusf(dtraw[idx] + i_ssd_dt_bias[jl * 32 + (idx & 31)]);
}

DEVI void ssd_chunk_scan(const Params& p, int jl, int g, int r0, int nv, float* acsS, float* dtS) {
  const float* i_ssd_a_log = PIN(14);
  const int lane = TID() & 63, w = TID() >> 6;
  const int h = g * 4 + w;
  const float* dt = (const float*)(PW(char, W_arena) + S_DT);
  const float a = -__expf(i_ssd_a_log[jl * 32 + h]);
  const float dtv = (lane < nv) ? dt[(size_t)(r0 + lane) * 32 + h] : 0.f;
  float v = dtv * a;
#pragma unroll
  for (int d = 1; d < 64; d <<= 1) {
    const float tv = __shfl_up(v, d);
    if (lane >= d) v += tv;
  }
  acsS[w * 64 + lane] = v;
  dtS[w * 64 + lane] = dtv;
}

DEVI void phase_ssd_a(const Params& p, int jl, char* smem) {
  char* ar = PW(char, W_arena);
  const bf16* xT = (const bf16*)(ar + S_XT);
  const bf16* BT = (const bf16*)(ar + S_BT);
  bf16* CS = (bf16*)(ar + S_CS);
  float* CD = (float*)(ar + S_CD);
  bf16* Bs = (bf16*)smem;
  bf16* As = Bs + 128 * 72;
  float* acsS = (float*)(As + 64 * 72);
  float* dtS = acsS + 256;
  const int tid = TID(), lane = tid & 63, wave = tid >> 6;
  for (int tl = BID(); tl < NCH * 8; tl += gridDim.x) {
    const int ci = tl >> 3, g = tl & 7;
    int r0, nv;
    chunk_rows(ci, r0, nv);
    ssd_chunk_scan(p, jl, g, r0, nv, acsS, dtS);
#pragma unroll
    for (int i = 0; i < 4; ++i) {
      const int id = tid + 256 * i, n = id >> 3, kc = (id & 7) * 8;
      *(uint4*)(Bs + n * 72 + kc) = *(const uint4*)(BT + ((size_t)ci * 1024 + g * 128 + n) * 64 + kc);
    }
    __syncthreads();
    if (lane == 63) CD[ci * 32 + g * 4 + wave] = __expf(acsS[wave * 64 + 63]);
#pragma unroll 1
    for (int hh = 0; hh < 4; ++hh) {
      const int h = g * 4 + hh;
      {
        const int pr = tid >> 2, lq = (tid & 3) * 16;
        const bf16* src = xT + ((size_t)ci * 2048 + h * 64 + pr) * 64 + lq;
        const uint4 a0 = *(const uint4*)src, a1 = *(const uint4*)(src + 8);
        const unsigned a[8] = {a0.x, a0.y, a0.z, a0.w, a1.x, a1.y, a1.z, a1.w};
        const float aend = acsS[hh * 64 + 63];
        unsigned o[8];
#pragma unroll
        for (int e = 0; e < 8; ++e) {
          const int l0 = lq + 2 * e;
          const float w0 = dtS[hh * 64 + l0] * __expf(aend - acsS[hh * 64 + l0]);
          const float w1 = dtS[hh * 64 + l0 + 1] * __expf(aend - acsS[hh * 64 + l0 + 1]);
          o[e] = pack2(bflo(a[e]) * w0, bfhi(a[e]) * w1);
        }
        uint4 q0, q1;
        q0.x = o[0]; q0.y = o[1]; q0.z = o[2]; q0.w = o[3]; q1.x = o[4]; q1.y = o[5]; q1.z = o[6]; q1.w = o[7];
        *(uint4*)(As + pr * 72 + lq) = q0;
        *(uint4*)(As + pr * 72 + lq + 8) = q1;
      }
      __syncthreads();
      const int wp = wave >> 1, wn = wave & 1;
#pragma unroll
      for (int j = 0; j < 2; ++j) {
        f32x16 acc = zero16();
        acc = mma_lds(As + (wp * 32) * 72, 72, Bs + (wn * 64 + j * 32) * 72, 72, 64, acc, lane);
        bf16* dst = CS + ((size_t)(ci * 32 + h) * 64) * 128;
#pragma unroll
        for (int r = 0; r < 16; ++r) {
          const int pp = wp * 32 + accrow(r, lane), n = wn * 64 + j * 32 + (lane & 31);
          dst[pp * 128 + n] = f2bf(acc[r]);
        }
      }
      __syncthreads();
    }
  }
}

DEVI void phase_ssd_b(const Params& p, int jl, char* smem) {
  const float* i_state_ssm = PIN(4);
  char* ar = PW(char, W_arena);
  bf16* CS = (bf16*)(ar + S_CS);
  const float* CD = (const float*)(ar + S_CD);
  float* outp = POUT;
  const size_t gtid = (size_t)BID() * 256 + TID(), nth = (size_t)gridDim.x * 256;
  for (size_t it = gtid; it < (size_t)17 * 65536; it += nth) {
    const int seq = (int)(it >> 16), e4 = (int)(it & 65535) * 4;
    const int h = e4 >> 13;
    if (seq == 0) {
      float s0 = 0.f, s1 = 0.f, s2 = 0.f, s3 = 0.f;
      for (int c0 = 0; c0 < 257; c0 += 16) {
        uint2 cv[16];
        float cd[16];
#pragma unroll
        for (int u = 0; u < 16; ++u) {
          const int ci = min(c0 + u, 256);
          cv[u] = *(const uint2*)(CS + (size_t)ci * 262144 + e4);
          cd[u] = CD[ci * 32 + h];
        }
#pragma unroll
        for (int u = 0; u < 16; ++u) {
          if (c0 + u < 257) {
            uint2 o;
            o.x = pack2(s0, s1); o.y = pack2(s2, s3);
            *(uint2*)(CS + (size_t)(c0 + u) * 262144 + e4) = o;
            s0 = s0 * cd[u] + bflo(cv[u].x); s1 = s1 * cd[u] + bfhi(cv[u].x);
            s2 = s2 * cd[u] + bflo(cv[u].y); s3 = s3 * cd[u] + bfhi(cv[u].y);
          }
        }
      }
      *(float4*)(outp + O_SSMP + (size_t)jl * 262144 + e4) = make_float4(s0, s1, s2, s3);
    } else {
      const int b = seq - 1, ci = 257 + b;
      const float4 sa = *(const float4*)(i_state_ssm + ((size_t)(jl * 16 + b)) * 262144 + e4);
      const uint2 cv = *(const uint2*)(CS + (size_t)ci * 262144 + e4);
      const float cd = CD[ci * 32 + h];
      uint2 o;
      o.x = pack2(sa.x, sa.y); o.y = pack2(sa.z, sa.w);
      *(uint2*)(CS + (size_t)ci * 262144 + e4) = o;
      *(float4*)(outp + O_SSMS + ((size_t)(jl * 16 + b)) * 262144 + e4) =
          make_float4(sa.x * cd + bflo(cv.x), sa.y * cd + bfhi(cv.x), sa.z * cd + bflo(cv.y), sa.w * cd + bfhi(cv.y));
    }
  }
  if (jl == 0 && BID() >= 256 && gridDim.x > 256) convert_weights(p, smem, 1, BID() - 256, gridDim.x - 256);
}

DEVI void phase_ssd_c(const Params& p, int jl, char* smem) {
  const float* i_ssd_d = PIN(15);
  char* ar = PW(char, W_arena);
  const bf16* xc = (const bf16*)(ar + S_XC);
  const bf16* xT = (const bf16*)(ar + S_XT);
  const bf16* CS = (const bf16*)(ar + S_CS);
  bf16* ys = (bf16*)(ar + S_YS);
  bf16* Cs = (bf16*)smem;
  bf16* Bs = Cs + 64 * 136;
  bf16* Gs = Bs + 64 * 136;
  bf16* Xs = Gs + 64 * 72;
  float* acsS = (float*)(Xs + 64 * 72);
  float* dtS = acsS + 256;
  const int tid = TID(), lane = tid & 63, wave = tid >> 6;
  const int wl = wave >> 1, w2 = wave & 1;
  for (int tl = BID(); tl < NCH * 8; tl += gridDim.x) {
    const int ci = tl >> 3, g = tl & 7;
    int r0, nv;
    chunk_rows(ci, r0, nv);
    ssd_chunk_scan(p, jl, g, r0, nv, acsS, dtS);
#pragma unroll
    for (int i = 0; i < 4; ++i) {
      const int id = tid + 256 * i, l = id >> 4, kc = (id & 15) * 8;
      uint4 cvv = make_uint4(0, 0, 0, 0), bvv = make_uint4(0, 0, 0, 0);
      if (l < nv) {
        cvv = *(const uint4*)(xc + (size_t)(r0 + l) * 4096 + 3072 + g * 128 + kc);
        bvv = *(const uint4*)(xc + (size_t)(r0 + l) * 4096 + 2048 + g * 128 + kc);
      }
      *(uint4*)(Cs + l * 136 + kc) = cvv;
      *(uint4*)(Bs + l * 136 + kc) = bvv;
    }
    __syncthreads();
    f32x16 cb = zero16();
    cb = mma_lds(Cs + (wl * 32) * 136, 136, Bs + (w2 * 32) * 136, 136, 128, cb, lane);
    __syncthreads();
#pragma unroll 1
    for (int hh = 0; hh < 4; ++hh) {
      const int h = g * 4 + hh;
      {
        const int s = w2 * 32 + (lane & 31);
        const float as = acsS[hh * 64 + s], ds = dtS[hh * 64 + s];
#pragma unroll
        for (int r = 0; r < 16; ++r) {
          const int l = wl * 32 + accrow(r, lane);
          const float gv = (s <= l) ? cb[r] * __expf(acsS[hh * 64 + l] - as) * ds : 0.f;
          Gs[l * 72 + s] = f2bf(gv);
        }
      }
#pragma unroll
      for (int i = 0; i < 2; ++i) {
        const int id = tid + 256 * i, pr = id >> 3, kc = (id & 7) * 8;
        *(uint4*)(Xs + pr * 72 + kc) = *(const uint4*)(xT + ((size_t)ci * 2048 + h * 64 + pr) * 64 + kc);
      }
#pragma unroll
      for (int i = 0; i < 4; ++i) {
        const int id = tid + 256 * i, pr = id >> 4, kc = (id & 15) * 8;
        *(uint4*)(Bs + pr * 136 + kc) = *(const uint4*)(CS + ((size_t)(ci * 32 + h) * 64 + pr) * 128 + kc);
      }
      __syncthreads();
      f32x16 a1 = zero16(), a2 = zero16();
      a1 = mma_lds(Gs + (wl * 32) * 72, 72, Xs + (w2 * 32) * 72, 72, 64, a1, lane);
      a2 = mma_lds(Cs + (wl * 32) * 136, 136, Bs + (w2 * 32) * 136, 136, 128, a2, lane);
      const float dsk = i_ssd_d[jl * 32 + h];
      const int pp = w2 * 32 + (lane & 31);
      const bf16* xcp = xc + (size_t)r0 * 4096 + h * 64 + pp;
      bf16* ysp = ys + (size_t)r0 * 2048 + h * 64 + pp;
      const float* acp = acsS + hh * 64;
#pragma unroll
      for (int r = 0; r < 16; ++r) {
        const int l = wl * 32 + accrow(r, lane);
        if (l < nv) {
          const float xv = bf2f(xcp[l * 4096]);
          const float yv = a1[r] + __expf(acp[l]) * a2[r] + dsk * xv;
          ysp[l * 2048] = f2bf(yv);
        }
      }
      __syncthreads();
    }
  }
}

DEVI void phase_ssd_d(const Params& p, int jl) {
  const float* i_ssd_norm_w = PIN(16);
  char* ar = PW(char, W_arena);
  const bf16* ys = (const bf16*)(ar + S_YS);
  const bf16* zb = (const bf16*)(ar + S_ZB);
  bf16* Yb = (bf16*)(ar + S_YB);
  const float* nw = i_ssd_norm_w + (size_t)jl * 2048;
  const int lane = TID() & 63;
  const int gw = BID() * 4 + (TID() >> 6), nwv = gridDim.x * 4;
  float nwr[32];
#pragma unroll
  for (int i = 0; i < 4; ++i)
#pragma unroll
    for (int e = 0; e < 8; ++e) nwr[i * 8 + e] = nw[(i * 64 + lane) * 8 + e];
  for (int m = gw; m < M; m += nwv) {
    float u[32];
    float ss = 0.f;
#pragma unroll
    for (int i = 0; i < 4; ++i) {
      const int c = (i * 64 + lane) * 8;
      const uint4 yv = *(const uint4*)(ys + (size_t)m * 2048 + c);
      const uint4 zv = *(const uint4*)(zb + (size_t)m * 2048 + c);
      const unsigned ya[4] = {yv.x, yv.y, yv.z, yv.w}, za[4] = {zv.x, zv.y, zv.z, zv.w};
#pragma unroll
      for (int e = 0; e < 4; ++e) {
        const float u0 = bflo(ya[e]) * siluf(bflo(za[e])), u1 = bfhi(ya[e]) * siluf(bfhi(za[e]));
        u[i * 8 + 2 * e] = u0; u[i * 8 + 2 * e + 1] = u1;
        ss += u0 * u0 + u1 * u1;
      }
    }
    const float rs = rsqrtf(wave_sum(ss) * (1.f / 2048.f) + 1e-5f);
#pragma unroll
    for (int i = 0; i < 4; ++i) {
      const int c = (i * 64 + lane) * 8;
      uint4 o;
      o.x = pack2(u[i * 8 + 0] * rs * nwr[i * 8 + 0], u[i * 8 + 1] * rs * nwr[i * 8 + 1]);
      o.y = pack2(u[i * 8 + 2] * rs * nwr[i * 8 + 2], u[i * 8 + 3] * rs * nwr[i * 8 + 3]);
      o.z = pack2(u[i * 8 + 4] * rs * nwr[i * 8 + 4], u[i * 8 + 5] * rs * nwr[i * 8 + 5]);
      o.w = pack2(u[i * 8 + 6] * rs * nwr[i * 8 + 6], u[i * 8 + 7] * rs * nwr[i * 8 + 7]);
      *(uint4*)(Yb + (size_t)m * 2048 + c) = o;
    }
  }
}

DEVI void da_convert_cache(const Params& p, char* smem) {
  const float* i_cache_k = PIN(2);
  const float* i_cache_v = PIN(3);
  char* ar = PW(char, W_arena);
  bf16* Kall = (bf16*)(ar + A_KALL);
  bf16* VTp = (bf16*)(ar + A_VTP);
  bf16* VTs = (bf16*)(ar + A_VTS);
  const int tid = TID();
  const size_t gtid = (size_t)BID() * 256 + tid, nth = (size_t)gridDim.x * 256;
  for (size_t i0 = gtid; i0 < (size_t)NB * 4096 * 128; i0 += nth * 4) {
    float4 v0[4], v1[4];
#pragma unroll
    for (int u = 0; u < 4; ++u) {
      const size_t idx = i0 + u * nth;
      if (idx < (size_t)NB * 4096 * 128) {
        const float* src = i_cache_k + (idx >> 7) * 1024 + (int)(idx & 127) * 8;
        v0[u] = *(const float4*)src; v1[u] = *(const float4*)(src + 4);
      }
    }
#pragma unroll
    for (int u = 0; u < 4; ++u) {
      const size_t idx = i0 + u * nth;
      if (idx < (size_t)NB * 4096 * 128) {
        const size_t rowi = idx >> 7;
        const int c = (int)(idx & 127) * 8;
        const int b = (int)(rowi >> 12), pos = (int)(rowi & 4095);
        uint4 o;
        o.x = pack2(v0[u].x, v0[u].y); o.y = pack2(v0[u].z, v0[u].w); o.z = pack2(v1[u].x, v1[u].y); o.w = pack2(v1[u].z, v1[u].w);
        *(uint4*)(Kall + ((size_t)LDVP + (size_t)b * LDVS + 48 + pos) * 1024 + c) = o;
      }
    }
  }
  for (size_t idx = gtid; idx < (size_t)17 * 48 * 128; idx += nth) {
    const int seq = (int)(idx / (48 * 128)), rem = (int)(idx % (48 * 128));
    const size_t rb = (seq == 0) ? 0 : (size_t)LDVP + (size_t)(seq - 1) * LDVS;
    *(uint4*)(Kall + (rb + (rem >> 7)) * 1024 + (rem & 127) * 8) = make_uint4(0, 0, 0, 0);
  }
  for (size_t idx = gtid; idx < (size_t)(1024 + NB * 1024) * 6; idx += nth) {
    const size_t rowi = idx / 6;
    const int c = (int)(idx % 6) * 8;
    bf16* dst = (rowi < 1024) ? VTp + rowi * LDVP + c : VTs + (rowi - 1024) * LDVS + c;
    *(uint4*)dst = make_uint4(0, 0, 0, 0);
  }
  float* tile = (float*)smem;
  for (int tl = BID(); tl < NB * 8 * 64; tl += gridDim.x) {
    const int b = tl >> 9, h = (tl >> 6) & 7, pt = tl & 63;
    for (int e = tid; e < 64 * 32; e += 256) {
      const int pos = e >> 5, c4 = (e & 31) * 4;
      const float4 v = *(const float4*)(i_cache_v + (((size_t)b * 4096 + pt * 64 + pos) * 8 + h) * 128 + c4);
      tile[pos * 129 + c4] = v.x; tile[pos * 129 + c4 + 1] = v.y; tile[pos * 129 + c4 + 2] = v.z; tile[pos * 129 + c4 + 3] = v.w;
    }
    __syncthreads();
    for (int e = tid; e < 1024; e += 256) {
      const int ee = e & 127, pg = (e >> 7) * 8;
      uint4 o;
      o.x = pack2(tile[(pg + 0) * 129 + ee], tile[(pg + 1) * 129 + ee]);
      o.y = pack2(tile[(pg + 2) * 129 + ee], tile[(pg + 3) * 129 + ee]);
      o.z = pack2(tile[(pg + 4) * 129 + ee], tile[(pg + 5) * 129 + ee]);
      o.w = pack2(tile[(pg + 6) * 129 + ee], tile[(pg + 7) * 129 + ee]);
      *(uint4*)(VTs + ((size_t)(b * 8 + h) * 128 + ee) * LDVS + 48 + pt * 64 + pg) = o;
    }
    __syncthreads();
  }
}

DEVI void attn_item(const Params& p, int seq, int qt, int h, float lam, char* smem) {
  const float* i_da_subln_g = PIN(20);
  char* ar = PW(char, W_arena);
  const bf16* Qb = (const bf16*)(ar + A_QB);
  const bf16* Kbase = (const bf16*)(ar + A_KALL) + ((seq == 0) ? (size_t)0 : ((size_t)LDVP + (size_t)(seq - 1) * LDVS)) * 1024;
  const int ldv = (seq == 0) ? LDVP : LDVS;
  const bf16* VTbase = (seq == 0) ? (const bf16*)(ar + A_VTP) + (size_t)h * 128 * LDVP
                                  : (const bf16*)(ar + A_VTS) + (size_t)((seq - 1) * 8 + h) * 128 * LDVS;
  bf16* Ks = (bf16*)smem;
  bf16* Vs = Ks + 2 * 64 * 72;
  const int tid = TID(), lane = tid & 63, wave = tid >> 6;
  const int c = wave >> 1, rh = wave & 1, hl = lane >> 5;
  const int u = 64 * qt + 32 * rh + (lane & 31);
  int m;
  bool qvalid;
  if (seq == 0) { m = u - 48; qvalid = (m >= 0) && (m < TP); }
  else { const int t = u - 4144; m = TP + 16 * (seq - 1) + t; qvalid = t >= 0; }
  bf16x8 qf[4];
  {
    const bf16x8 zv = {0, 0, 0, 0, 0, 0, 0, 0};
    const bf16* qp = Qb + (size_t)(qvalid ? m : 0) * 1024 + h * 128 + c * 64 + hl * 8;
#pragma unroll
    for (int ks = 0; ks < 4; ++ks) {
      const bf16x8 ld = *(const bf16x8*)(qp + ks * 16);
      qf[ks] = qvalid ? ld : zv;
    }
  }
  f32x16 O[4];
#pragma unroll
  for (int et = 0; et < 4; ++et) O[et] = zero16();
  float mrun = -1e30f, lrun = 0.f;
  const float sc = 0.125f * 1.4426950408889634f;
  const int ntiles = qt + 1;
  u32x4 rk[4], rv[4];
  const int k_row = (tid >> 3) & 63;
#define ATT_LOAD(j)                                                                                          \
  {                                                                                                          \
    _Pragma("unroll") for (int i = 0; i < 4; ++i) {                                                          \
      const int id = tid + 256 * i;                                                                          \
      const int cc = id >> 9, row = (id >> 3) & 63, kc = (id & 7) * 8;                                       \
      rk[i] = *(const u32x4*)(Kbase + (size_t)(64 * (j) + row) * 1024 + h * 128 + cc * 64 + kc);             \
      const int e = id >> 3;                                                                                 \
      rv[i] = *(const u32x4*)(VTbase + (size_t)e * ldv + 64 * (j) + kc);                                     \
    }                                                                                                        \
  }
  (void)k_row;
  constexpr int ABUF = 2 * 64 * 72 + 128 * 68;
#define ATT_STORE(buf)                                                                                       \
  {                                                                                                          \
    bf16* Kd = Ks + (buf) * ABUF;                                                                            \
    bf16* Vd = Kd + 2 * 64 * 72;                                                                             \
    _Pragma("unroll") for (int i = 0; i < 4; ++i) {                                                          \
      const int id = tid + 256 * i;                                                                          \
      const int cc = id >> 9, row = (id >> 3) & 63, kc = (id & 7) * 8;                                       \
      *(u32x4*)(Kd + (cc * 64 + row) * 72 + kc) = rk[i];                                                     \
      const int e = id >> 3;                                                                                 \
      *(uint2*)(Vd + e * 68 + kc) = make_uint2(rv[i].x, rv[i].y);                                            \
      *(uint2*)(Vd + e * 68 + kc + 4) = make_uint2(rv[i].z, rv[i].w);                                        \
    }                                                                                                        \
  }
  ATT_LOAD(0);
  __syncthreads();
  ATT_STORE(0);
  if (ntiles > 1) ATT_LOAD(1);
  __syncthreads();
  for (int j = 0; j < ntiles; ++j) {
    const int cur = j & 1;
    if (j + 1 < ntiles) ATT_STORE(cur ^ 1);
    if (j + 2 < ntiles) ATT_LOAD(j + 2);
    const bf16* Kc = Ks + cur * ABUF;
    const bf16* Vc = Kc + 2 * 64 * 72;
    f32x16 S[2];
#pragma unroll
    for (int kt2 = 0; kt2 < 2; ++kt2) {
      S[kt2] = zero16();
#pragma unroll
      for (int ks = 0; ks < 4; ++ks) {
        const bf16x8 a = *(const bf16x8*)(Kc + (c * 64 + kt2 * 32 + (lane & 31)) * 72 + ks * 16 + hl * 8);
        S[kt2] = mfma32(a, qf[ks], S[kt2]);
      }
      __builtin_amdgcn_sched_barrier(0);
    }
    if (j == 0) {
#pragma unroll
      for (int kt2 = 0; kt2 < 2; ++kt2)
#pragma unroll
        for (int r = 0; r < 16; ++r)
          if (kt2 * 32 + accrow(r, lane) < 48) S[kt2][r] = -1e30f;
    }
    float mx = -1e30f;
#pragma unroll
    for (int kt2 = 0; kt2 < 2; ++kt2)
#pragma unroll
      for (int r = 0; r < 16; ++r) mx = fmaxf(mx, S[kt2][r]);
    mx = fmaxf(mx, __shfl_xor(mx, 32));
    const float mnew = fmaxf(mrun, mx);
    const float msc = mnew * sc;
    float ps = 0.f;
#pragma unroll
    for (int kt2 = 0; kt2 < 2; ++kt2)
#pragma unroll
      for (int r = 0; r < 16; ++r) {
        const float pv = __builtin_amdgcn_exp2f(S[kt2][r] * sc - msc);
        S[kt2][r] = pv;
        ps += pv;
      }
    if (__any(mnew > mrun)) {
      const float alpha = __builtin_amdgcn_exp2f((mrun - mnew) * sc);
      lrun *= alpha;
#pragma unroll
      for (int et = 0; et < 4; ++et)
#pragma unroll
        for (int r = 0; r < 16; ++r) O[et][r] *= alpha;
    }
    mrun = mnew;
    lrun += ps;
    bf16x8 pf[4];
#pragma unroll
    for (int s = 0; s < 4; ++s) {
      union { u32x4 q; bf16x8 v; } cvp;
#pragma unroll
      for (int e = 0; e < 4; ++e) cvp.q[e] = pack2(S[s >> 1][(s & 1) * 8 + 2 * e], S[s >> 1][(s & 1) * 8 + 2 * e + 1]);
      pf[s] = cvp.v;
    }
#pragma unroll
    for (int et = 0; et < 4; ++et) {
#pragma unroll
      for (int s = 0; s < 4; ++s) {
        const bf16* vp = Vc + (et * 32 + (lane & 31)) * 68 + 16 * s + 4 * hl;
        const uint2 v0 = *(const uint2*)vp, v1 = *(const uint2*)(vp + 8);
        union { uint4 q; bf16x8 v; } cv;
        cv.q = make_uint4(v0.x, v0.y, v1.x, v1.y);
        O[et] = mfma32(cv.v, pf[s], O[et]);
      }
      __builtin_amdgcn_sched_barrier(0);
    }
    __syncthreads();
  }
#undef ATT_LOAD
#undef ATT_STORE
  const float ltot = lrun + __shfl_xor(lrun, 32);
  const float inv = 1.f / ltot;
  __syncthreads();
  float* Ox = (float*)smem;
  if (c == 1) {
#pragma unroll
    for (int et = 0; et < 4; ++et)
#pragma unroll
      for (int r = 0; r < 16; ++r) Ox[(rh * 128 + et * 32 + accrow(r, lane)) * 32 + (lane & 31)] = O[et][r] * inv;
  }
  __syncthreads();
  if (c == 0) {
    float ss = 0.f;
#pragma unroll
    for (int et = 0; et < 4; ++et)
#pragma unroll
      for (int r = 0; r < 16; ++r) {
        const float o = O[et][r] * inv - lam * Ox[(rh * 128 + et * 32 + accrow(r, lane)) * 32 + (lane & 31)];
        O[et][r] = o;
        ss += o * o;
      }
    ss += __shfl_xor(ss, 32);
    const float scl = rsqrtf(ss * (1.f / 128.f) + 1e-5f) * (1.f - LAM_INIT);
    if (qvalid) {
      bf16* Ob = (bf16*)(ar + A_OB) + (size_t)m * 1024 + h * 128;
#pragma unroll
      for (int et = 0; et < 4; ++et)
#pragma unroll
        for (int rq = 0; rq < 4; ++rq) {
          const int e0 = et * 32 + 8 * rq + 4 * hl;
          const float4 gg = *(const float4*)(i_da_subln_g + e0);
          uint2 o;
          o.x = pack2(O[et][rq * 4 + 0] * scl * gg.x, O[et][rq * 4 + 1] * scl * gg.y);
          o.y = pack2(O[et][rq * 4 + 2] * scl * gg.z, O[et][rq * 4 + 3] * scl * gg.w);
          *(uint2*)(Ob + e0) = o;
        }
    }
  }
  __syncthreads();
}

DEVI void phase_attn(const Params& p, char* smem, int cidx = 0) {
  const float* i_da_lambda = PIN(19);
  __shared__ int s_item;
  float l1 = 0.f, l2 = 0.f;
  for (int i = 0; i < 64; ++i) {
    l1 += i_da_lambda[i] * i_da_lambda[64 + i];
    l2 += i_da_lambda[128 + i] * i_da_lambda[192 + i];
  }
  const float lam = __expf(l1) - __expf(l2) + LAM_INIT;
  while (true) {
    if (TID() == 0) s_item = atomicAdd(PW(int, W_counters) + cidx, 1);
    __syncthreads();
    const int it = s_item;
    __syncthreads();
    if (it >= 2184) break;
    int seq, qt, h;
    if (it < 1536) { seq = 0; qt = 256 - (it >> 3); h = it & 7; }
    else if (it < 1664) { const int j = it - 1536; seq = 1 + (j >> 3); qt = 64; h = j & 7; }
    else { const int j = it - 1664; seq = 0; qt = 64 - (j >> 3); h = j & 7; }
    attn_item(p, seq, qt, h, lam, smem);
  }
}

DEVI void phase_rk_mix(const Params& p) {
  const float* i_state_shift = PIN(7);
  const float* i_rk_mu = PIN(22);
  const size_t gtid = (size_t)BID() * 256 + TID(), nth = (size_t)gridDim.x * 256;
  bf16* mix = (bf16*)(PW(char, W_arena) + R_MIX);
  const int c = (int)(gtid & 255) * 4;
  float4 mur[6];
#pragma unroll
  for (int k = 0; k < 6; ++k) mur[k] = *(const float4*)(i_rk_mu + (size_t)k * 1024 + c);
  for (size_t idx = gtid; idx < (size_t)M * 256; idx += nth) {
    const int m = (int)(idx >> 8);
    int b = -1, t = m, L = TP;
    if (m >= TP) { b = (m - TP) >> 4; t = (m - TP) & 15; L = 16; }
    const uint2 xb = *(const uint2*)(PW(bf16, W_Xb) + (size_t)m * 1024 + c);
    const float4 x = make_float4(bflo(xb.x), bfhi(xb.x), bflo(xb.y), bfhi(xb.y));
    float4 xp = make_float4(0, 0, 0, 0);
    if (t > 0) {
      const uint2 pb = *(const uint2*)(PW(bf16, W_Xb) + (size_t)(m - 1) * 1024 + c);
      xp = make_float4(bflo(pb.x), bfhi(pb.x), bflo(pb.y), bfhi(pb.y));
    } else if (b >= 0) xp = *(const float4*)(i_state_shift + (size_t)b * 1024 + c);
    const float4 xx = make_float4(xp.x - x.x, xp.y - x.y, xp.z - x.z, xp.w - x.w);
#pragma unroll
    for (int k = 0; k < 6; ++k) {
      const float4 mu = mur[k];
      uint2 o;
      o.x = pack2(x.x + xx.x * mu.x, x.y + xx.y * mu.y);
      o.y = pack2(x.z + xx.z * mu.z, x.w + xx.w * mu.w);
      *(uint2*)(mix + (size_t)k * MP * 1024 + (size_t)m * 1024 + c) = o;
    }
    if (t == L - 1) {
      float* so = (b < 0) ? POUT + O_SHP + c : POUT + O_SHS + (size_t)b * 1024 + c;
      *(float4*)so = x;
    }
  }
}

DEVI void phase_rk_g1(const Params& p, char* smem) {
  char* ar = PW(char, W_arena);
  const bf16* mix = (const bf16*)(ar + R_MIX);
  const int NTT = 28, total = MT * NTT;
  for (int id = BID(); id < total; id += gridDim.x) {
    int mt, ntg;
    tile_decode(id, NTT, mt, ntg);
    GJob jb;
    jb.lda = 1024; jb.K = 1024; jb.aux = 0; jb.of = nullptr;
    int nt;
    if (ntg < 8) { jb.A = mix + (size_t)0 * MP * 1024; jb.Bt = PW(bf16, W_wt_r); jb.epi = EPI_BF16; jb.of = (float*)(ar + R_R); nt = ntg; }
    else if (ntg < 16) { jb.A = mix + (size_t)2 * MP * 1024; jb.Bt = PW(bf16, W_wt_k); jb.epi = EPI_BF16; jb.of = (float*)(ar + R_K); nt = ntg - 8; }
    else if (ntg < 24) { jb.A = mix + (size_t)3 * MP * 1024; jb.Bt = PW(bf16, W_wt_v); jb.epi = EPI_BF16; jb.of = (float*)(ar + R_V); nt = ntg - 16; }
    else if (ntg == 24) { jb.A = mix + (size_t)1 * MP * 1024; jb.Bt = PW(bf16, W_wt_w1); jb.epi = EPI_RK_W1; nt = 0; }
    else if (ntg == 25) { jb.A = mix + (size_t)4 * MP * 1024; jb.Bt = PW(bf16, W_wt_a1); jb.epi = EPI_RK_A1; nt = 0; }
    else { jb.A = mix + (size_t)5 * MP * 1024; jb.Bt = PW(bf16, W_wt_g1); jb.epi = EPI_RK_G1; nt = ntg - 26; }
    gemm_tile(p, jb, mt * 128, nt * 128, smem);
  }
}

DEVI void phase_rk_g2(const Params& p, char* smem) {
  char* ar = PW(char, W_arena);
  const int NTT = 24, total = MT * NTT;
  for (int id = BID(); id < total; id += gridDim.x) {
    int mt, ntg;
    tile_decode(id, NTT, mt, ntg);
    GJob jb;
    jb.aux = 0; jb.of = nullptr;
    int nt;
    if (ntg < 8) { jb.A = (const bf16*)(ar + R_HW); jb.lda = 64; jb.K = 64; jb.Bt = PW(bf16, W_wt_w2); jb.epi = EPI_RK_W2; nt = ntg; }
    else if (ntg < 16) { jb.A = (const bf16*)(ar + R_HA); jb.lda = 64; jb.K = 64; jb.Bt = PW(bf16, W_wt_a2); jb.epi = EPI_RK_A2; nt = ntg - 8; }
    else { jb.A = (const bf16*)(ar + R_HG); jb.lda = 192; jb.K = 192; jb.Bt = PW(bf16, W_wt_g2); jb.epi = EPI_BF16; jb.of = (float*)(ar + R_G); nt = ntg - 16; }
    gemm_tile(p, jb, mt * 128, nt * 128, smem);
  }
}

DEVI void phase_rk_prep(const Params& p) {
  const float* i_rk_k_k = PIN(31);
  const float* i_rk_k_a = PIN(32);
  char* ar = PW(char, W_arena);
  bf16* Kr = (bf16*)(ar + R_K);
  const bf16* A = (const bf16*)(ar + R_A);
  bf16* KK = (bf16*)(ar + R_KK);
  bf16* BV = (bf16*)(ar + R_BV);
  const int lane = TID() & 63;
  const int gw = BID() * 4 + (TID() >> 6), nw = gridDim.x * 4;
  int cc = -1;
  float kkw = 0.f, kaw = 0.f;
  for (int i0 = gw; i0 < M * 16; i0 += nw * 4) {
    float kv[4], av[4];
#pragma unroll
    for (int u = 0; u < 4; ++u) {
      const int it = min(i0 + u * nw, M * 16 - 1);
      const size_t o = (size_t)(it >> 4) * 1024 + (it & 15) * 64 + lane;
      kv[u] = bf2f(Kr[o]); av[u] = bf2f(A[o]);
    }
#pragma unroll
    for (int u = 0; u < 4; ++u) {
      const int it = i0 + u * nw;
      const int c = (min(it, M * 16 - 1) & 15) * 64 + lane;
      if (c != cc) { cc = c; kkw = i_rk_k_k[c]; kaw = i_rk_k_a[c]; }
      const float kk = kv[u] * kkw;
      const float nrm = sqrtf(wave_sum(kk * kk));
      if (it < M * 16) {
        const size_t o = (size_t)(it >> 4) * 1024 + c;
        const float kkn = kk / fmaxf(nrm, 1e-12f);
        Kr[o] = f2bf(kv[u] * (1.f + (av[u] - 1.f) * kaw));
        KK[o] = f2bf(kkn);
        BV[o] = f2bf(kkn * av[u]);
      }
    }
  }
}

DEVI void phase_rk_scan(const Params& p, char* smem) {
  const float* i_state_wkv = PIN(6);
  char* ar = PW(char, W_arena);
  const bf16* src0 = (const bf16*)(ar + R_R);
  const float* src1 = (const float*)(ar + R_W);
  const bf16* src2 = (const bf16*)(ar + R_K);
  const bf16* src3 = (const bf16*)(ar + R_KK);
  const bf16* src4 = (const bf16*)(ar + R_BV);
  const bf16* src5 = (const bf16*)(ar + R_V);
  float* Y = (float*)(ar + R_Y);
  float* outp = POUT;
  float* st = (float*)smem;
  const int tid = TID(), lane = tid & 63, wave = tid >> 6;
  float* yb = st + 6 * 32 * 64 + wave * (16 * 68);
  for (int it = BID(); it < 256 + 4096; it += gridDim.x) {
    int b, h, rg, mbase, L;
    if (it < 256) { b = -1; h = it & 15; rg = it >> 4; mbase = 0; L = TP; }
    else { const int j = it - 256; b = j >> 8; h = (j >> 4) & 15; rg = j & 15; mbase = TP + 16 * b; L = 16; }
    const int row = rg * 4 + wave;
    float S = (b < 0) ? 0.f : i_state_wkv[((size_t)(b * 16 + h) * 64 + row) * 64 + lane];
    const int nst = (L + 31) >> 5;
    f32x4 rgw[2];
    uint2 rgb[10];
    const int lr = (tid >> 4), lc4 = (tid & 15) * 4;
#define RK_LOAD(s)                                                                             \
  {                                                                                            \
    _Pragma("unroll") for (int hf = 0; hf < 2; ++hf) {                                         \
      const int tt = (s) * 32 + lr + 16 * hf;                                                  \
      const size_t go = (size_t)(mbase + tt) * 1024 + h * 64 + lc4;                            \
      const f32x4 zz = {0.f, 0.f, 0.f, 0.f};                                                   \
      const bool ok = tt < L;                                                                  \
      rgw[hf] = ok ? *(const f32x4*)(src1 + go) : zz;                                          \
      rgb[0 + hf] = ok ? *(const uint2*)(src0 + go) : make_uint2(0, 0);                        \
      rgb[2 + hf] = ok ? *(const uint2*)(src2 + go) : make_uint2(0, 0);                        \
      rgb[4 + hf] = ok ? *(const uint2*)(src3 + go) : make_uint2(0, 0);                        \
      rgb[6 + hf] = ok ? *(const uint2*)(src4 + go) : make_uint2(0, 0);                        \
      rgb[8 + hf] = ok ? *(const uint2*)(src5 + go) : make_uint2(0, 0);                        \
    }                                                                                          \
  }
    RK_LOAD(0);
    for (int s = 0; s < nst; ++s) {
      __syncthreads();
#pragma unroll
      for (int hf = 0; hf < 2; ++hf) {
        const int rr = lr + 16 * hf;
        *(f32x4*)(st + (1 * 32 + rr) * 64 + lc4) = rgw[hf];
#pragma unroll
        for (int a5 = 0; a5 < 5; ++a5) {
          const int arr = (a5 == 0) ? 0 : a5 + 1;
          const uint2 q = rgb[2 * a5 + hf];
          *(f32x4*)(st + (arr * 32 + rr) * 64 + lc4) = f32x4{bflo(q.x), bfhi(q.x), bflo(q.y), bfhi(q.y)};
        }
      }
      __syncthreads();
      if (s + 1 < nst) RK_LOAD(s + 1);
      const int nstep = min(32, L - s * 32);
      for (int q0 = 0; q0 < nstep; q0 += 16) {
#pragma unroll
        for (int g8 = 0; g8 < 16; g8 += 8) {
          float r_[8], w_[8], k_[8], kk_[8], bv_[8], v_[8];
#pragma unroll
          for (int u = 0; u < 8; ++u) {
            const int q = q0 + g8 + u;
            r_[u] = st[(0 * 32 + q) * 64 + lane]; w_[u] = st[(1 * 32 + q) * 64 + lane]; k_[u] = st[(2 * 32 + q) * 64 + lane];
            kk_[u] = st[(3 * 32 + q) * 64 + lane]; bv_[u] = st[(4 * 32 + q) * 64 + lane]; v_[u] = st[(5 * 32 + q) * 64 + row];
          }
#pragma unroll
          for (int u = 0; u < 8; ++u) {
            const float base = S * w_[u] + v_[u] * k_[u];
            const float sa = wave_sum63(S * kk_[u]);
            S = base - sa * bv_[u];
            yb[(g8 + u) * 68 + lane] = S * r_[u];
          }
        }
        if (lane < 16) {
          const float* yr = yb + lane * 68;
          f32x4 acc = *(const f32x4*)yr;
#pragma unroll
          for (int j = 1; j < 16; ++j) acc += *(const f32x4*)(yr + 4 * j);
          Y[(size_t)(mbase + s * 32 + q0 + lane) * 1024 + h * 64 + row] = (acc[0] + acc[1]) + (acc[2] + acc[3]);
        }
      }
    }
#undef RK_LOAD
    float* so = (b < 0) ? outp + O_WKVP + ((size_t)h * 64 + row) * 64 + lane
                        : outp + O_WKVS + ((size_t)(b * 16 + h) * 64 + row) * 64 + lane;
    *so = S;
  }
  if (BID() >= 256 && gridDim.x > 256) {
    __syncthreads();
    convert_weights(p, smem, 2, BID() - 256, gridDim.x - 256);
  }
}

DEVI void phase_rk_post(const Params& p) {
  const float* i_rk_lnx_g = PIN(38);
  const float* i_rk_lnx_b = PIN(39);
  const float* i_rk_r_k = PIN(33);
  char* ar = PW(char, W_arena);
  const float* Y = (const float*)(ar + R_Y);
  const bf16* R = (const bf16*)(ar + R_R);
  const bf16* Kr = (const bf16*)(ar + R_K);
  const bf16* V = (const bf16*)(ar + R_V);
  const bf16* G = (const bf16*)(ar + R_G);
  bf16* Yb = (bf16*)(ar + R_YB);
  const int lane = TID() & 63;
  const int gw = BID() * 4 + (TID() >> 6), nw = gridDim.x * 4;
  int cc = -1;
  float lg = 0.f, lb = 0.f, rkw = 0.f;
  for (int i0 = gw; i0 < M * 16; i0 += nw * 4) {
    float y[4], rk[4], vv[4], gg[4];
#pragma unroll
    for (int u = 0; u < 4; ++u) {
      const int it = min(i0 + u * nw, M * 16 - 1);
      const size_t o = (size_t)(it >> 4) * 1024 + (it & 15) * 64 + lane;
      y[u] = Y[o]; rk[u] = bf2f(R[o]) * bf2f(Kr[o]); vv[u] = bf2f(V[o]); gg[u] = bf2f(G[o]);
    }
#pragma unroll
    for (int u = 0; u < 4; ++u) {
      const int it = i0 + u * nw;
      const int c = (min(it, M * 16 - 1) & 15) * 64 + lane;
      if (c != cc) { cc = c; lg = i_rk_lnx_g[c]; lb = i_rk_lnx_b[c]; rkw = i_rk_r_k[c]; }
      const float mean = wave_sum(y[u]) * (1.f / 64.f);
      const float dy = y[u] - mean;
      const float var = wave_sum(dy * dy) * (1.f / 64.f);
      const float yn = dy * rsqrtf(var + 64e-5f) * lg + lb;
      const float bonus = wave_sum(rk[u] * rkw) * vv[u];
      if (it < M * 16) Yb[(size_t)(it >> 4) * 1024 + c] = f2bf((yn + bonus) * gg[u]);
    }
  }
}

enum {
  OP_PREP = 0, OP_SSD_IN, OP_SSD_E1, OP_SSD_A, OP_SSD_B, OP_SSD_C, OP_SSD_D, OP_SSD_OUT, OP_LN, OP_FFN_GU, OP_FFN_E,
  OP_FFN_DOWN, OP_QKV, OP_ATTN, OP_DA_O, OP_RK_MIX, OP_RK_G1, OP_RK_G2, OP_RK_PREP, OP_RK_SCAN, OP_RK_POST, OP_RK_O
};
constexpr int NPH = 43;
__constant__ unsigned char PROG[NPH][2] = {
    {OP_PREP, 0},
    {OP_SSD_IN, 0}, {OP_SSD_E1, 0}, {OP_SSD_A, 0}, {OP_SSD_B, 0}, {OP_SSD_C, 0}, {OP_SSD_D, 0}, {OP_SSD_OUT, 0}, {OP_LN, 0},
    {OP_FFN_GU, 0}, {OP_FFN_DOWN, 0}, {OP_LN, 1},
    {OP_QKV, 0}, {OP_ATTN, 0}, {OP_DA_O, 0}, {OP_LN, 2},
    {OP_FFN_GU, 1}, {OP_FFN_DOWN, 1}, {OP_LN, 3},
    {OP_RK_MIX, 0}, {OP_RK_G1, 0}, {OP_RK_G2, 0}, {OP_RK_PREP, 0}, {OP_RK_SCAN, 0}, {OP_RK_POST, 0}, {OP_RK_O, 0}, {OP_LN, 4},
    {OP_FFN_GU, 2}, {OP_FFN_DOWN, 2}, {OP_LN, 5},
    {OP_SSD_IN, 1}, {OP_SSD_E1, 1}, {OP_SSD_A, 1}, {OP_SSD_B, 1}, {OP_SSD_C, 1}, {OP_SSD_D, 1}, {OP_SSD_OUT, 1}, {OP_LN, 6},
    {OP_FFN_GU, 3}, {OP_FFN_DOWN, 3}, {OP_LN, 7}};

DEVI void run_op(const Params& p, const int op, const int a, char* smem) {
  GJob jb;
  jb.aux = 0; jb.of = nullptr;
  switch (op) {
    case OP_PREP: phase_prep(p, smem); break;
    case OP_SSD_IN:
      jb.A = PW(bf16, W_Xb); jb.lda = 1024; jb.K = 1024; jb.Bt = PW(bf16, W_wt_ssd_in) + (size_t)a * 6272 * 1024; jb.epi = EPI_SSD_IN;
      gemm_single(p, jb, 49, smem);
      break;
    case OP_SSD_E1: phase_ssd_e1(p, a, smem); break;
    case OP_SSD_A: phase_ssd_a(p, a, smem); break;
    case OP_SSD_B: phase_ssd_b(p, a, smem); break;
    case OP_SSD_C: phase_ssd_c(p, a, smem); break;
    case OP_SSD_D: phase_ssd_d(p, a); break;
    case OP_SSD_OUT:
      jb.A = (const bf16*)(PW(char, W_arena) + S_YB); jb.lda = 2048; jb.K = 2048; jb.Bt = PW(bf16, W_wt_ssd_out) + (size_t)a * 1024 * 2048; jb.epi = EPI_RESID;
      gemm_single(p, jb, 8, smem);
      break;
    case OP_LN: phase_ln(p, a, a == 7); break;
    case OP_FFN_GU:
      jb.A = PW(bf16, W_Xb); jb.lda = 1024; jb.K = 1024; jb.Bt = PW(bf16, W_wt_gu) + (size_t)a * 5632 * 1024; jb.epi = EPI_GU; jb.aux = a;
      gemm_single(p, jb, 44, smem);
      break;
    case OP_FFN_E: phase_ffn_e(p, a); break;
    case OP_FFN_DOWN:
      jb.A = (const bf16*)(PW(char, W_arena) + F_HB); jb.lda = 2816; jb.K = 2816; jb.Bt = PW(bf16, W_wt_down) + (size_t)a * 1024 * 2816; jb.epi = EPI_RESID;
      gemm_single(p, jb, 8, smem);
      break;
    case OP_QKV:
      jb.A = PW(bf16, W_Xb); jb.lda = 1024; jb.K = 1024; jb.Bt = PW(bf16, W_wt_qkv); jb.epi = EPI_QKV;
      if (BID() & 1) { da_convert_cache(p, smem); gemm_single(p, jb, 24, smem); }
      else { gemm_single(p, jb, 24, smem); da_convert_cache(p, smem); }
      break;
    case OP_ATTN: phase_attn(p, smem); break;
    case OP_DA_O:
      jb.A = (const bf16*)(PW(char, W_arena) + A_OB); jb.lda = 1024; jb.K = 1024; jb.Bt = PW(bf16, W_wt_o); jb.epi = EPI_RESID;
      gemm_single(p, jb, 8, smem);
      break;
    case OP_RK_MIX: phase_rk_mix(p); break;
    case OP_RK_G1: phase_rk_g1(p, smem); break;
    case OP_RK_G2: phase_rk_g2(p, smem); break;
    case OP_RK_PREP: phase_rk_prep(p); break;
    case OP_RK_SCAN: phase_rk_scan(p, smem); break;
    case OP_RK_POST: phase_rk_post(p); break;
    case OP_RK_O:
      jb.A = (const bf16*)(PW(char, W_arena) + R_YB); jb.lda = 1024; jb.K = 1024; jb.Bt = PW(bf16, W_wt_ro); jb.epi = EPI_RESID;
      gemm_single(p, jb, 8, smem);
      break;
    default: break;
  }
}

#if MK_COOP
__global__ void __launch_bounds__(256, 2) mega(Params p, int ph_lo, int ph_hi) {
  __shared__ __attribute__((aligned(16))) char smem[SMEM_BYTES];
  unsigned* gw = (unsigned*)(p.ws + W_counters);
  const unsigned xcc = xcc_id();
  if (threadIdx.x == 0) add_agent(&gw[GB_XCNT + 64 * xcc], 1u);
  unsigned ncnt = 0, nx = 0, gen = 0;
  for (int ph = ph_lo; ph < ph_hi; ++ph) {
    run_op(p, PROG[ph][0], PROG[ph][1], smem);
#ifdef PROBE_REP
    {
      const int op = PROG[ph][0];
      const bool isg = (op == OP_SSD_IN || op == OP_SSD_OUT || op == OP_FFN_GU || op == OP_FFN_DOWN || op == OP_DA_O || op == OP_RK_G1 || op == OP_RK_G2 || op == OP_RK_O);
      if ((PROBE_REP & 1) && isg) run_op(p, op, PROG[ph][1], smem);
      if ((PROBE_REP & 256) && op == OP_FFN_GU) run_op(p, op, PROG[ph][1], smem);
      if ((PROBE_REP & 512) && op == OP_FFN_DOWN) run_op(p, op, PROG[ph][1], smem);
      if ((PROBE_REP & 1024) && op == OP_SSD_IN) run_op(p, op, PROG[ph][1], smem);
      if ((PROBE_REP & 2) && op == OP_ATTN) phase_attn(p, smem, 1);
      if ((PROBE_REP & 4) && op == OP_RK_SCAN) run_op(p, op, PROG[ph][1], smem);
      if ((PROBE_REP & 8) && (op == OP_LN || op == OP_FFN_E || op == OP_SSD_E1 || op == OP_SSD_D || op == OP_RK_MIX || op == OP_RK_POST)) run_op(p, op, PROG[ph][1], smem);
      if ((PROBE_REP & 32) && op == OP_PREP) run_op(p, op, PROG[ph][1], smem);
      if ((PROBE_REP & 64) && op == OP_QKV) run_op(p, op, PROG[ph][1], smem);
      if ((PROBE_REP & 16) && (op == OP_SSD_A || op == OP_SSD_C)) run_op(p, op, PROG[ph][1], smem);
    }
#endif
    if (ph + 1 < ph_hi) {
      if (ph == ph_lo) {
        if (ph_hi < 0) cg::this_grid().sync();
        asm volatile("s_waitcnt vmcnt(0) lgkmcnt(0)" ::: "memory");
        __syncthreads();
        if (threadIdx.x == 0) {
          __builtin_amdgcn_fence(__ATOMIC_RELEASE, "agent");
          asm volatile("s_waitcnt vmcnt(0)" ::: "memory");
          add_agent(&gw[64], 1u);
          gb_spin(&gw[64], gridDim.x);
          __builtin_amdgcn_fence(__ATOMIC_ACQUIRE, "agent");
          asm volatile("s_waitcnt vmcnt(0)" ::: "memory");
          ncnt = ld_agent(&gw[GB_XCNT + 64 * xcc]);
          for (int j = 0; j < 16; ++j) nx += (ld_agent(&gw[GB_XCNT + 64 * j]) != 0u) ? 1u : 0u;
        }
        __syncthreads();
      } else {
        ++gen;
        gbar(gw, xcc, ncnt, nx, gen);
#ifdef PROBE_REP
        if (PROBE_REP & 128) { ++gen; gbar(gw, xcc, ncnt, nx, gen); ++gen; gbar(gw, xcc, ncnt, nx, gen); }
#endif
      }
    }
  }
}
#endif

#if !MK_COOP
template <int OP>
__global__ void __launch_bounds__(256, 2) phase_kernel(Params p, int a) {
  __shared__ __attribute__((aligned(16))) char smem[SMEM_BYTES];
  run_op(p, OP, a, smem);
}

static const unsigned char PROG_H[NPH][2] = {
    {OP_PREP, 0},
    {OP_SSD_IN, 0}, {OP_SSD_E1, 0}, {OP_SSD_A, 0}, {OP_SSD_B, 0}, {OP_SSD_C, 0}, {OP_SSD_D, 0}, {OP_SSD_OUT, 0}, {OP_LN, 0},
    {OP_FFN_GU, 0}, {OP_FFN_DOWN, 0}, {OP_LN, 1},
    {OP_QKV, 0}, {OP_ATTN, 0}, {OP_DA_O, 0}, {OP_LN, 2},
    {OP_FFN_GU, 1}, {OP_FFN_DOWN, 1}, {OP_LN, 3},
    {OP_RK_MIX, 0}, {OP_RK_G1, 0}, {OP_RK_G2, 0}, {OP_RK_PREP, 0}, {OP_RK_SCAN, 0}, {OP_RK_POST, 0}, {OP_RK_O, 0}, {OP_LN, 4},
    {OP_FFN_GU, 2}, {OP_FFN_DOWN, 2}, {OP_LN, 5},
    {OP_SSD_IN, 1}, {OP_SSD_E1, 1}, {OP_SSD_A, 1}, {OP_SSD_B, 1}, {OP_SSD_C, 1}, {OP_SSD_D, 1}, {OP_SSD_OUT, 1}, {OP_LN, 6},
    {OP_FFN_GU, 3}, {OP_FFN_DOWN, 3}, {OP_LN, 7}};

template <int OP>
static void launch_op(const Params& p, int a, hipStream_t stream) {
  phase_kernel<OP><<<dim3(512), dim3(256), 0, stream>>>(p, a);
}
static void launch_phase(const Params& p, int op, int a, hipStream_t s) {
  switch (op) {
    case OP_PREP: launch_op<OP_PREP>(p, a, s); break;
    case OP_SSD_IN: launch_op<OP_SSD_IN>(p, a, s); break;
    case OP_SSD_E1: launch_op<OP_SSD_E1>(p, a, s); break;
    case OP_SSD_A: launch_op<OP_SSD_A>(p, a, s); break;
    case OP_SSD_B: launch_op<OP_SSD_B>(p, a, s); break;
    case OP_SSD_C: launch_op<OP_SSD_C>(p, a, s); break;
    case OP_SSD_D: launch_op<OP_SSD_D>(p, a, s); break;
    case OP_SSD_OUT: launch_op<OP_SSD_OUT>(p, a, s); break;
    case OP_LN: launch_op<OP_LN>(p, a, s); break;
    case OP_FFN_GU: launch_op<OP_FFN_GU>(p, a, s); break;
    case OP_FFN_E: launch_op<OP_FFN_E>(p, a, s); break;
    case OP_FFN_DOWN: launch_op<OP_FFN_DOWN>(p, a, s); break;
    case OP_QKV: launch_op<OP_QKV>(p, a, s); break;
    case OP_ATTN: launch_op<OP_ATTN>(p, a, s); break;
    case OP_DA_O: launch_op<OP_DA_O>(p, a, s); break;
    case OP_RK_MIX: launch_op<OP_RK_MIX>(p, a, s); break;
    case OP_RK_G1: launch_op<OP_RK_G1>(p, a, s); break;
    case OP_RK_G2: launch_op<OP_RK_G2>(p, a, s); break;
    case OP_RK_PREP: launch_op<OP_RK_PREP>(p, a, s); break;
    case OP_RK_SCAN: launch_op<OP_RK_SCAN>(p, a, s); break;
    case OP_RK_POST: launch_op<OP_RK_POST>(p, a, s); break;
    default: launch_op<OP_RK_O>(p, a, s); break;
  }
}

#endif

extern "C" void kernel_launch(void* const* d_in, const int* in_sizes, int n_in, void* d_out, int out_size, void* d_ws,
                              size_t ws_size, hipStream_t stream) {
  Params p{};
  for (int i = 0; i < 47; ++i) p.in[i] = (const float*)d_in[i];
  p.out = (float*)d_out;
  p.ws = (char*)d_ws;
  if (W_TOTAL > ws_size || n_in < 47) {
    fprintf(stderr, "workspace too small: need %zu have %zu\n", (size_t)W_TOTAL, ws_size);
    return;
  }
#if MK_COOP
  static int grid_blocks = 0;
  if (!grid_blocks) {
    int dev = 0, cus = 0, per_cu = 0;
    hipGetDevice(&dev);
    hipDeviceGetAttribute(&cus, hipDeviceAttributeMultiprocessorCount, dev);
    hipOccupancyMaxActiveBlocksPerMultiprocessor(&per_cu, mega, 256, 0);
    if (per_cu > 2) per_cu = 2;
    grid_blocks = cus * per_cu;
  }
  hipMemsetAsync((char*)d_ws + W_counters, 0, 16384, stream);
  int lo = 0, hi = NPH;
  void* args[] = {&p, &lo, &hi};
  hipError_t e = hipLaunchCooperativeKernel((void*)mega, dim3(grid_blocks), dim3(256), args, 0, stream);
  if (e != hipSuccess) fprintf(stderr, "cooperative launch failed: %s (grid %d)\n", hipGetErrorString(e), grid_blocks);
#else
  for (int ph = 0; ph < NPH; ++ph) launch_phase(p, PROG_H[ph][0], PROG_H[ph][1], stream);
#endif
}
```
